# Optimizing an MI355X kernel written in HIP

```python
import jax, jax.numpy as jnp
from jax import lax
import numpy as np

D_MODEL = 1024
BATCH = 8
SEQ = 2048
DEPTH = 2

GRID_W = 64
CTX_LEN = 256
MIX_W = D_MODEL
N_MIXERS = 4
GROUP_W = MIX_W // N_MIXERS
HEAD_DIM = 64
A_HEADS = GROUP_W // HEAD_DIM
A_KV_HEADS = A_HEADS // 2
A_WINDOW = 128
A_BLOCK = 128
B_CHUNK = 128
B_GROUPS = 4
B_GROUP_W = GROUP_W // B_GROUPS
C_POOLS = (2, 4, 8, 16)
C_GROUP_W = GROUP_W // len(C_POOLS)
D_HEADS = GROUP_W // HEAD_DIM
D_WIN_ROWS = 8
D_WIN_COLS = 16
FF_DIM = ((8 * D_MODEL + 3 * 256 - 1) // (3 * 256)) * 256
ROPE_BASE = 10000.0
NORM_EPS = 1e-6
NEG_INF = -1e30
IN_WIDTHS = (A_HEADS * HEAD_DIM, A_KV_HEADS * HEAD_DIM, A_KV_HEADS * HEAD_DIM,
             GROUP_W, GROUP_W,
             GROUP_W,
             D_HEADS * HEAD_DIM, D_HEADS * HEAD_DIM, D_HEADS * HEAD_DIM)
IN_TOTAL = sum(IN_WIDTHS)

kernel_name = "hymba_style_hybrid_dit_block"


def rms_norm(x, g):
    xf = x.astype(jnp.float32)
    y = xf * lax.rsqrt(jnp.mean(xf * xf, axis=-1, keepdims=True) + NORM_EPS)
    return (y * g.astype(jnp.float32)).astype(x.dtype)


def layer_norm(x, g):
    xf = x.astype(jnp.float32)
    mu = jnp.mean(xf, axis=-1, keepdims=True)
    var = jnp.mean(jnp.square(xf - mu), axis=-1, keepdims=True)
    return ((xf - mu) * lax.rsqrt(var + NORM_EPS) * g.astype(jnp.float32)).astype(x.dtype)


def modulate(h, shift, scale):
    return h * (1 + scale) + shift


def heads(t, n):
    return t.reshape(t.shape[:-1] + (n, HEAD_DIM))


def split_cols(p):
    offs = np.cumsum(IN_WIDTHS)[:-1].tolist()
    return jnp.split(p, offs, axis=-1)


def col_block(w, i):
    start = sum(IN_WIDTHS[:i])
    return w[:, start:start + IN_WIDTHS[i]]


def rope_1d(x, pos):
    half = x.shape[-1] // 2
    inv = jnp.power(ROPE_BASE, -jnp.arange(half, dtype=jnp.float32) / half)
    ang = pos.astype(jnp.float32)[:, None] * inv[None, :]
    cos = jnp.cos(ang)[None, :, None, :]
    sin = jnp.sin(ang)[None, :, None, :]
    xf = x.astype(jnp.float32)
    x1, x2 = xf[..., :half], xf[..., half:]
    return jnp.concatenate([x1 * cos - x2 * sin, x1 * sin + x2 * cos], axis=-1).astype(x.dtype)


def axial_rope(x, rows, cols):
    h = x.shape[-1] // 2
    return jnp.concatenate([rope_1d(x[..., :h], rows), rope_1d(x[..., h:], cols)], axis=-1)


def window_attention(q, k, v, kc, vc, sink):
    b, s, nh, dh = q.shape
    nkv = k.shape[2]
    g = nh // nkv
    nb = s // A_BLOCK
    scale = dh ** -0.5
    qb = q.reshape(b, nb, A_BLOCK, nkv, g, dh)
    pad = ((0, 0), (A_BLOCK, A_BLOCK), (0, 0), (0, 0))
    kp = jnp.pad(k, pad).reshape(b, nb + 2, A_BLOCK, nkv, dh)
    vp = jnp.pad(v, pad).reshape(b, nb + 2, A_BLOCK, nkv, dh)
    kb = jnp.concatenate([kp[:, :-2], kp[:, 1:-1], kp[:, 2:]], axis=2)
    vb = jnp.concatenate([vp[:, :-2], vp[:, 1:-1], vp[:, 2:]], axis=2)
    s_loc = jnp.einsum('bnqhgd,bnkhd->bnhgqk', qb, kb).astype(jnp.float32) * scale
    blk = jnp.arange(nb)[:, None, None]
    qpos = blk * A_BLOCK + jnp.arange(A_BLOCK)[None, :, None]
    kpos = (blk - 1) * A_BLOCK + jnp.arange(3 * A_BLOCK)[None, None, :]
    valid = (jnp.abs(kpos - qpos) <= A_WINDOW) & (kpos >= 0) & (kpos < s)
    s_loc = jnp.where(valid[None, :, None, None], s_loc, NEG_INF)
    s_ctx = jnp.einsum('bnqhgd,blhd->bnhgql', qb, kc).astype(jnp.float32) * scale
    s_sink = jnp.broadcast_to(sink.astype(jnp.float32).reshape(nkv, g)[None, None, :, :, None, None],
                              s_loc.shape[:-1] + (1,))
    probs = jax.nn.softmax(jnp.concatenate([s_loc, s_ctx, s_sink], axis=-1), axis=-1)
    nloc = 3 * A_BLOCK
    nctx = kc.shape[1]
    p_loc = probs[..., :nloc].astype(v.dtype)
    p_ctx = probs[..., nloc:nloc + nctx].astype(v.dtype)
    out = (jnp.einsum('bnhgqk,bnkhd->bnqhgd', p_loc, vb)
           + jnp.einsum('bnhgql,blhd->bnqhgd', p_ctx, vc))
    return out.reshape(b, s, nh * dh)


def context_attention(qc, kc, vc, sink):
    b, l, nh, dh = qc.shape
    nkv = kc.shape[2]
    g = nh // nkv
    qg = qc.reshape(b, l, nkv, g, dh)
    s = jnp.einsum('blhgd,bmhd->bhglm', qg, kc).astype(jnp.float32) * dh ** -0.5
    if sink is not None:
        s_sink = jnp.broadcast_to(sink.astype(jnp.float32).reshape(nkv, g)[None, :, :, None, None],
                                  s.shape[:-1] + (1,))
        s = jnp.concatenate([s, s_sink], axis=-1)
    probs = jax.nn.softmax(s, axis=-1)[..., :l].astype(vc.dtype)
    out = jnp.einsum('bhglm,bmhd->blhgd', probs, vc)
    return out.reshape(b, l, nh * dh)


def neighbourhood_attention(q, k, v, kc, vc, rpb):
    b, s, nh, dh = q.shape
    rows = s // GRID_W
    kh = min(D_WIN_ROWS, rows)
    kw = D_WIN_COLS
    scale = dh ** -0.5
    qg = q.reshape(b, rows, GRID_W, nh, dh)
    kg = k.reshape(b, rows, GRID_W, nh, dh)
    vg = v.reshape(b, rows, GRID_W, nh, dh)
    r = jnp.arange(rows)
    cidx = jnp.arange(GRID_W)
    row_start = jnp.clip(r - kh // 2, 0, rows - kh)
    row_idx = row_start[:, None] + jnp.arange(kh)[None, :]
    k_rows = kg[:, row_idx]
    v_rows = vg[:, row_idx]
    s_loc = jnp.einsum('brchd,brkwhd->bhrckw', qg, k_rows).astype(jnp.float32) * scale
    col_start = jnp.clip(cidx - kw // 2, 0, GRID_W - kw)
    col_ok = (cidx[None, :] >= col_start[:, None]) & (cidx[None, :] < col_start[:, None] + kw)
    roff = row_idx - r[:, None] + (D_WIN_ROWS - 1)
    coff = jnp.clip(cidx[None, :] - cidx[:, None], -(kw - 1), kw - 1) + (D_WIN_COLS - 1)
    bias = rpb[:, roff[:, None, :, None], coff[None, :, None, :]]
    s_loc = jnp.where(col_ok[None, None, None, :, None, :], s_loc + bias.astype(jnp.float32)[None], NEG_INF)
    nloc = kh * GRID_W
    s_loc = s_loc.reshape(b, nh, rows, GRID_W, nloc)
    s_ctx = jnp.einsum('brchd,blhd->bhrcl', qg, kc).astype(jnp.float32) * scale
    probs = jax.nn.softmax(jnp.concatenate([s_loc, s_ctx], axis=-1), axis=-1)
    p_loc = probs[..., :nloc].reshape(b, nh, rows, GRID_W, kh, GRID_W).astype(v.dtype)
    p_ctx = probs[..., nloc:].astype(v.dtype)
    out = (jnp.einsum('bhrckw,brkwhd->brchd', p_loc, v_rows)
           + jnp.einsum('bhrcl,blhd->brchd', p_ctx, vc))
    return out.reshape(b, s, nh * dh)


def spatial_gating(u, v, v_gain, w_s, b_s):
    b, n, _ = u.shape
    nc = n // B_CHUNK
    u = jax.nn.gelu(u)
    v = layer_norm(jax.nn.gelu(v), v_gain)
    vc = v.reshape(b, nc, B_CHUNK, B_GROUPS, B_GROUP_W)
    z = jnp.einsum('gpq,bnqgc->bnpgc', w_s, vc) + b_s.T[None, None, :, :, None]
    return u * z.reshape(b, n, GROUP_W)


def multiscale_pool(y, w_pool, scale):
    b, n, ch = y.shape
    yf = y.astype(jnp.float32)
    cs = jnp.concatenate([jnp.zeros((b, 1, ch), jnp.float32), jnp.cumsum(yf, axis=1)], axis=1)
    t = jnp.arange(n)
    outs = []
    for gi, w in enumerate(C_POOLS):
        sl = slice(gi * C_GROUP_W, (gi + 1) * C_GROUP_W)
        lo = jnp.clip(t - w // 2, 0, n)
        hi = jnp.clip(t - w // 2 + w, 0, n)
        csg = cs[..., sl]
        cnt = (hi - lo).astype(jnp.float32)[None, :, None]
        pooled = (csg[:, hi] - csg[:, lo]) / cnt - yf[..., sl]
        outs.append(jnp.einsum('bnc,cd->bnd', pooled.astype(y.dtype), w_pool[gi]))
    return jnp.concatenate(outs, axis=-1) * scale


def swiglu(h, wg, wu, wd):
    return (jax.nn.silu(h @ wg) * (h @ wu)) @ wd


def setup_inputs(seed: int = 0) -> dict:
    key = jax.random.key(seed)
    ks = jax.random.split(key, 24)
    f32 = jnp.float32

    def nrm(k, shape, s):
        return jax.random.normal(k, shape, f32) * s

    D, L = D_MODEL, DEPTH
    return {
        "x": nrm(ks[0], (BATCH, SEQ, D), 1.0),
        "c": nrm(ks[1], (BATCH, D), 1.0),
        "ctx": nrm(ks[2], (BATCH, CTX_LEN, D), 1.0),
        "c_ctx": nrm(ks[3], (D,), 1.0),
        "w_mod": nrm(ks[4], (L, D, 6 * D), 0.5 * D ** -0.5),
        "b_mod": nrm(ks[5], (L, 6 * D), 0.02),
        "g_mix": 1.0 + nrm(ks[6], (L, D), 0.05),
        "g_ffn": 1.0 + nrm(ks[7], (L, D), 0.05),
        "w_in": nrm(ks[8], (L, D, IN_TOTAL), D ** -0.5),
        "w_out": nrm(ks[9], (L, MIX_W, D), MIX_W ** -0.5),
        "a_q_gain": 1.0 + nrm(ks[10], (L, HEAD_DIM), 0.05),
        "a_k_gain": 1.0 + nrm(ks[11], (L, HEAD_DIM), 0.05),
        "a_sink": nrm(ks[12], (L, A_HEADS), 0.5),
        "b_v_gain": 1.0 + nrm(ks[13], (L, GROUP_W), 0.05),
        "b_w_s": nrm(ks[14], (L, B_GROUPS, B_CHUNK, B_CHUNK), B_CHUNK ** -0.5),
        "b_b_s": 1.0 + nrm(ks[15], (L, B_GROUPS, B_CHUNK), 0.02),
        "c_w_pool": nrm(ks[16], (L, len(C_POOLS), C_GROUP_W, C_GROUP_W), C_GROUP_W ** -0.5),
        "c_scale": 1.0 + nrm(ks[17], (L, GROUP_W), 0.1),
        "d_q_gain": 1.0 + nrm(ks[18], (L, HEAD_DIM), 0.05),
        "d_k_gain": 1.0 + nrm(ks[19], (L, HEAD_DIM), 0.05),
        "d_rpb": nrm(ks[20], (L, D_HEADS, 2 * D_WIN_ROWS - 1, 2 * D_WIN_COLS - 1), 0.1),
        "w_gate": nrm(ks[21], (L, D, FF_DIM), D ** -0.5),
        "w_up": nrm(ks[22], (L, D, FF_DIM), D ** -0.5),
        "w_down": nrm(ks[23], (L, FF_DIM, D), FF_DIM ** -0.5),
    }


def reference(x, c, ctx, c_ctx, w_mod, b_mod, g_mix, g_ffn, w_in, w_out, a_q_gain, a_k_gain, a_sink,
              b_v_gain, b_w_s, b_b_s, c_w_pool, c_scale, d_q_gain, d_k_gain, d_rpb, w_gate, w_up, w_down):
    s = x.shape[1]
    t = jnp.arange(s)
    row_pos = t // GRID_W
    col_pos = t % GRID_W
    xc = ctx
    c_act = jax.nn.silu(c)
    cc_act = jax.nn.silu(c_ctx)
    for l in range(DEPTH):
        last = l == DEPTH - 1
        mod = (c_act @ w_mod[l] + b_mod[l])[:, None, :]
        sh1, sc1, g1, sh2, sc2, g2 = jnp.split(mod, 6, axis=-1)
        modc = cc_act @ w_mod[l] + b_mod[l]
        csh1, csc1, cg1, csh2, csc2, cg2 = jnp.split(modc, 6, axis=-1)

        h = modulate(rms_norm(x, g_mix[l]), sh1, sc1)
        hc = modulate(rms_norm(xc, g_mix[l]), csh1, csc1)
        aq, ak, av, bu, bv, cin, dq, dk, dv = split_cols(h @ w_in[l])
        if last:
            cak, cav, cdk, cdv = [hc @ col_block(w_in[l], i) for i in (1, 2, 7, 8)]
        else:
            caq, cak, cav, cbu, cbv, ccin, cdq, cdk, cdv = split_cols(hc @ w_in[l])

        kc_a = rms_norm(heads(cak, A_KV_HEADS), a_k_gain[l])
        vc_a = heads(cav, A_KV_HEADS)
        kc_d = rms_norm(heads(cdk, D_HEADS), d_k_gain[l])
        vc_d = heads(cdv, D_HEADS)

        q_a = axial_rope(rms_norm(heads(aq, A_HEADS), a_q_gain[l]), row_pos, col_pos)
        k_a = axial_rope(rms_norm(heads(ak, A_KV_HEADS), a_k_gain[l]), row_pos, col_pos)
        out_a = window_attention(q_a, k_a, heads(av, A_KV_HEADS), kc_a, vc_a, a_sink[l])
        out_b = spatial_gating(bu, bv, b_v_gain[l], b_w_s[l], b_b_s[l])
        out_c = multiscale_pool(cin, c_w_pool[l], c_scale[l])
        out_d = neighbourhood_attention(rms_norm(heads(dq, D_HEADS), d_q_gain[l]),
                                        rms_norm(heads(dk, D_HEADS), d_k_gain[l]),
                                        heads(dv, D_HEADS), kc_d, vc_d, d_rpb[l])
        mix = jnp.concatenate([out_a, out_b, out_c, out_d], axis=-1) @ w_out[l]
        x = x + g1 * mix
        x = x + g2 * swiglu(modulate(rms_norm(x, g_ffn[l]), sh2, sc2), w_gate[l], w_up[l], w_down[l])

        if not last:
            oc_a = context_attention(rms_norm(heads(caq, A_HEADS), a_q_gain[l]), kc_a, vc_a, a_sink[l])
            oc_b = spatial_gating(cbu, cbv, b_v_gain[l], b_w_s[l], b_b_s[l])
            oc_c = multiscale_pool(ccin, c_w_pool[l], c_scale[l])
            oc_d = context_attention(rms_norm(heads(cdq, D_HEADS), d_q_gain[l]), kc_d, vc_d, None)
            mixc = jnp.concatenate([oc_a, oc_b, oc_c, oc_d], axis=-1) @ w_out[l]
            xc = xc + cg1 * mixc
            xc = xc + cg2 * swiglu(modulate(rms_norm(xc, g_ffn[l]), csh2, csc2), w_gate[l], w_up[l], w_down[l])
    return x
```

```cpp
#include <hip/hip_runtime.h>
#include <hip/hip_cooperative_groups.h>
#include <cstdio>
#include <cstdint>
namespace cg = cooperative_groups;
namespace pg8 {
#define PG8_LAS __attribute__((address_space(3)))
typedef unsigned short bf16_t;
typedef short bf16x8 __attribute__((ext_vector_type(8)));
typedef float f32x4 __attribute__((ext_vector_type(4)));
typedef unsigned u32x4 __attribute__((ext_vector_type(4)));
constexpr int BM = 256, BK = 64, HALF = 128, HTB = HALF * BK * 2  , STAGE_BYTES = 8 * HTB, NXCD = 8, WGM = 8;

__host__ __device__ __forceinline__ int lds_byte(int r, int c) { const int st = (r >> 4) * 2 + (c >> 5), rr = r & 15, cc = c & 31, ob = rr * 64 + cc * 2; return st * 1024 + (ob ^ (((ob >> 9) & 1) << 5)); }
__host__ __device__ __forceinline__ void stage_rc(int b, int& R, int& C) { const int st = b / 1024, sb = b % 1024, swz = sb ^ (((sb >> 9) & 1) << 5); R = (st >> 1) * 16 + swz / 64; C = (st & 1) * 32 + (swz % 64) / 2; }
__host__ __device__ __forceinline__ int perm32(int rho) { const int n = rho >> 4, i = rho & 15; return 8 * (i >> 2) + 4 * n + (i & 3); }

struct Unit { int pm, pn, pk; };
struct Gemm { const bf16_t* A; const bf16_t* Bt; int M, N, K, ld; };

struct StaticOrder {
    int nM, nN, nwg, G, c;
    __host__ __device__ void init(int M, int N, int G_, int c_) { nM = M / BM; nN = N / BM; nwg = nM * nN; G = G_; c = c_; }
    __host__ __device__ bool next(int i, Unit& u) const {
        const long L = (long)i * G + c; if (L >= nwg) return false;
        int wgid = (int)L; { const int q = nwg / NXCD, r = nwg % NXCD, xcd = wgid % NXCD, off = wgid / NXCD; wgid = (xcd < r ? xcd * (q + 1) : r * (q + 1) + (xcd - r) * q) + off; }
        const int wgm = (nM % 9 == 0) ? 9 : WGM;
        const int nig = wgm * nN, gid = wgid / nig, fm = gid * wgm, gsz = (nM - fm) < wgm ? (nM - fm) : wgm;
        u.pm = fm + ((wgid % nig) % gsz); u.pn = (wgid % nig) / gsz; u.pk = 0; return true;
    }
    __device__ __forceinline__ void a_ready(const Unit&) const {}
    __device__ __forceinline__ void done(const Unit&) const {}
};

__device__ __forceinline__ unsigned cvt_pk_bf16(float lo, float hi) { unsigned r; asm volatile("v_cvt_pk_bf16_f32 %0, %1, %2" : "=v"(r) : "v"(lo), "v"(hi)); return r; }
typedef float f32x2 __attribute__((ext_vector_type(2)));
__device__ __forceinline__ f32x2 gelu_pk(f32x2 v) {
    const f32x2 av = __builtin_elementwise_abs(v), d = av * 0.2316418882f + 1.0f;
    f32x2 t; t.x = __builtin_amdgcn_rcpf(d.x); t.y = __builtin_amdgcn_rcpf(d.y);
    f32x2 q = t * 0.5307027145f + (-0.7265760135f); q = q * t + 0.7107068705f; q = q * t + (-0.142248368f); q = q * t + 0.127414796f; q = q * t;
    const f32x2 s = (v * v) * (-0.72134752044f);
    f32x2 e; e.x = __builtin_amdgcn_exp2f(s.x); e.y = __builtin_amdgcn_exp2f(s.y);
    const f32x2 m = v * (q * e), r = v - m;
    f32x2 o; o.x = v.x < 0.f ? m.x : r.x; o.y = v.y < 0.f ? m.y : r.y; return o;
}

template <int ACT  > struct EpiBf16 {
    static constexpr bool PERM = true, AFTER_DRAIN = false; static_assert(ACT == 0 || ACT == 1, "EpiBf16: ACT is 0 (none) or 1 (gelu_pk)");
    bf16_t* O; int ldc; const float* bias; int split_cols; size_t split_stride; float scale0;
    __device__ __forceinline__ void operator()(const f32x4 (&acc)[2][2][4][2], const Unit& u, int wr, int wc, int fr, int fq) const {
        const int row0 = u.pm * BM + wr * 64 + fr; int colt = u.pn * BM; bf16_t* base = O;
        float sc = 1.f; if (split_cols) { const int t = colt / split_cols; base += (size_t)t * split_stride; colt -= t * split_cols; if (t == 0) sc = scale0; }
        const int col0 = colt + wc * 32 + 8 * fq, bcol0 = u.pn * BM + wc * 32 + 8 * fq;
        f32x4 bv[2][2];
#pragma unroll
        for (int bj = 0; bj < 2; ++bj)
#pragma unroll
            for (int n = 0; n < 2; ++n) bv[bj][n] = bias ? *(const f32x4*)(bias + bcol0 + bj * HALF + 4 * n) : (f32x4){0.f, 0.f, 0.f, 0.f};
#pragma unroll
        for (int ai = 0; ai < 2; ++ai)
#pragma unroll
            for (int m = 0; m < 4; ++m) { bf16_t* rowp = base + (size_t)(row0 + ai * HALF + m * 16) * ldc + col0;
#pragma unroll
                for (int bj = 0; bj < 2; ++bj) { f32x4 v0 = acc[ai][bj][m][0] + bv[bj][0], v1 = acc[ai][bj][m][1] + bv[bj][1];
                    if (ACT == 1) { f32x2 a = gelu_pk((f32x2){v0[0], v0[1]}), b = gelu_pk((f32x2){v0[2], v0[3]}), c = gelu_pk((f32x2){v1[0], v1[1]}), d = gelu_pk((f32x2){v1[2], v1[3]});
                        v0 = (f32x4){a.x, a.y, b.x, b.y}; v1 = (f32x4){c.x, c.y, d.x, d.y}; }
                    v0 = v0 * sc; v1 = v1 * sc; u32x4 w; w.x = cvt_pk_bf16(v0[0], v0[1]); w.y = cvt_pk_bf16(v0[2], v0[3]); w.z = cvt_pk_bf16(v1[0], v1[1]); w.w = cvt_pk_bf16(v1[2], v1[3]);
                    *(u32x4*)(rowp + bj * HALF) = w; } }
    }
};
template <class Epi, class Sched, bool ALIGN_EPI = false, bool SP2 = false>
__device__ __forceinline__ void gemm_phase(PG8_LAS unsigned char* lds, const Gemm g, const Sched& S, const Epi& E) {
    const int tid = threadIdx.x, wid = __builtin_amdgcn_readfirstlane(tid >> 6), lane = tid & 63, wr = wid >> 2, wc = wid & 3, fr = lane & 15, fq = lane >> 4;
    const int K = g.K, nt = K / BK;
    unsigned voffA[2], voffB[2];
#pragma unroll
    for (int i = 0; i < 2; ++i) { int R, C; stage_rc(tid * 16 + i * 8192, R, C); const int Rb = Epi::PERM ? ((R & ~31) + perm32(R & 31)) : R;
        voffA[i] = (unsigned)(R * g.ld + C) * 2u; voffB[i] = (unsigned)(Rb * g.ld + C) * 2u; }
    const size_t kstep = (size_t)(BK * 2);
    const size_t hstep = (size_t)HALF * g.ld * 2;
    const size_t tstep = 2 * hstep;
    const unsigned ldsw = (unsigned)wid * 1024u;
    const int aoff = lds_byte(wr * 64 + fr, fq * 8), boff = lds_byte(wc * 32 + fr, fq * 8);
#define PG8_SA(b, h) (((b) * 2 + (h)) * HTB)
#define PG8_SB(b, h) ((4 + (b) * 2 + (h)) * HTB)
#define PG8_STAGE(bufoff, gbase, voff) do { _Pragma("unroll") for (int _i = 0; _i < 2; ++_i) \
        __builtin_amdgcn_global_load_lds((const unsigned*)((const char*)(gbase) + (voff)[_i]), (PG8_LAS unsigned*)(lds + (bufoff) + ldsw + _i * 8192), 16, 0, 0); } while (0)
#define PG8_LDA(dst, b, h) do { _Pragma("unroll") for (int m = 0; m < 4; ++m) _Pragma("unroll") for (int k = 0; k < 2; ++k) dst[m][k] = *(const PG8_LAS bf16x8*)(lds + PG8_SA(b, h) + aoff + m * 2048 + k * 1024); } while (0)
#define PG8_LDB(dst, b, h) do { _Pragma("unroll") for (int n = 0; n < 2; ++n) _Pragma("unroll") for (int k = 0; k < 2; ++k) dst[n][k] = *(const PG8_LAS bf16x8*)(lds + PG8_SB(b, h) + boff + n * 2048 + k * 1024); } while (0)
#define PG8_MMA(ai, bj, At, Bt) do { __builtin_amdgcn_s_setprio(1); _Pragma("unroll") for (int m = 0; m < 4; ++m) _Pragma("unroll") for (int n = 0; n < 2; ++n) _Pragma("unroll") for (int k = 0; k < 2; ++k) \
        acc[ai][bj][m][n] = __builtin_amdgcn_mfma_f32_16x16x32_bf16(Bt[n][k], At[m][k], acc[ai][bj][m][n], 0, 0, 0); __builtin_amdgcn_s_setprio(0); } while (0)
#define PG8_WAIT_V(n) asm volatile("s_waitcnt vmcnt(" #n ")" ::: "memory")
#define PG8_WAIT_L(n) asm volatile("s_waitcnt lgkmcnt(" #n ")" ::: "memory")
#define PG8_BAR __builtin_amdgcn_s_barrier()
#define PG8_SCHED __builtin_amdgcn_sched_barrier(0)
    Unit cur, nxt; int ui = 0;
    if (!S.next(0, cur)) return;
    f32x4 acc[2][2][4][2];
#pragma unroll
    for (int a = 0; a < 2; ++a)
#pragma unroll
        for (int b = 0; b < 2; ++b)
#pragma unroll
            for (int m = 0; m < 4; ++m)
#pragma unroll
                for (int n = 0; n < 2; ++n) acc[a][b][m][n] = (f32x4){0.f, 0.f, 0.f, 0.f};
    bf16x8 At[4][2], B0[2][2], B1[2][2];
    const char* cA = (const char*)g.A + (size_t)cur.pm * tstep + (size_t)cur.pk * K * 2; const char* cB = (const char*)g.Bt + (size_t)cur.pn * tstep + (size_t)cur.pk * K * 2;
    S.a_ready(cur);
    if constexpr (SP2) {
        PG8_STAGE(PG8_SB(0, 0), cB, voffB); PG8_STAGE(PG8_SB(0, 1), cB + hstep, voffB); PG8_STAGE(PG8_SA(0, 0), cA, voffA); PG8_STAGE(PG8_SA(0, 1), cA + hstep, voffA);
        if (wr == 1) PG8_BAR;
        PG8_WAIT_V(2); PG8_BAR;
        PG8_STAGE(PG8_SB(1, 0), cB + kstep, voffB); PG8_STAGE(PG8_SA(1, 0), cA + kstep, voffA); PG8_STAGE(PG8_SB(1, 1), cB + hstep + kstep, voffB);
        PG8_WAIT_V(6); PG8_BAR;
    } else {
        PG8_STAGE(PG8_SB(0, 0), cB, voffB); PG8_STAGE(PG8_SA(0, 0), cA, voffA); PG8_STAGE(PG8_SB(0, 1), cB + hstep, voffB); PG8_STAGE(PG8_SA(0, 1), cA + hstep, voffA);
        if (wr == 1) PG8_BAR;
        PG8_WAIT_V(4); PG8_BAR;
        PG8_STAGE(PG8_SB(1, 0), cB + kstep, voffB); PG8_STAGE(PG8_SA(1, 0), cA + kstep, voffA); PG8_STAGE(PG8_SB(1, 1), cB + hstep + kstep, voffB);
        PG8_WAIT_V(6); PG8_BAR;
    }
    for (;;) {
        const bool has_next = S.next(ui + 1, nxt);
        const char* nA = has_next ? (const char*)g.A + (size_t)nxt.pm * tstep + (size_t)nxt.pk * K * 2 : cA; const char* nB = has_next ? (const char*)g.Bt + (size_t)nxt.pn * tstep + (size_t)nxt.pk * K * 2 : cB;
        for (int t = 0; t < nt; t += 2) {
            const bool last = (t == nt - 2);
            const char* a1 = cA + (size_t)(t + 1) * kstep;
            const char* a2 = last ? nA : cA + (size_t)(t + 2) * kstep; const char* b2 = last ? nB : cB + (size_t)(t + 2) * kstep;
            const char* a3 = a2 + kstep; const char* b3 = b2 + kstep;
            if (last && has_next) S.a_ready(nxt);
            if constexpr (SP2) {
            PG8_LDB(B0, 0, 0); PG8_LDB(B1, 0, 1); PG8_SCHED; PG8_LDA(At, 0, 0); PG8_STAGE(PG8_SA(1, 1), a1 + hstep, voffA);
            PG8_WAIT_V(8); PG8_WAIT_L(0); PG8_BAR; PG8_MMA(0, 0, At, B0); PG8_MMA(0, 1, At, B1); PG8_BAR; PG8_SCHED;
            PG8_LDA(At, 0, 1); PG8_STAGE(PG8_SB(0, 0), b2, voffB); PG8_STAGE(PG8_SB(0, 1), b2 + hstep, voffB); PG8_STAGE(PG8_SA(0, 0), a2, voffA);
            PG8_WAIT_V(8); PG8_WAIT_L(0); PG8_BAR; PG8_MMA(1, 0, At, B0); PG8_MMA(1, 1, At, B1); PG8_BAR; PG8_SCHED;
            PG8_LDB(B0, 1, 0); PG8_LDB(B1, 1, 1); PG8_SCHED; PG8_LDA(At, 1, 0); PG8_STAGE(PG8_SA(0, 1), a2 + hstep, voffA);
            PG8_WAIT_V(8); PG8_WAIT_L(0); PG8_BAR; PG8_MMA(0, 0, At, B0); PG8_MMA(0, 1, At, B1); PG8_BAR; PG8_SCHED;
            PG8_LDA(At, 1, 1); PG8_STAGE(PG8_SB(1, 0), b3, voffB); PG8_STAGE(PG8_SB(1, 1), b3 + hstep, voffB); PG8_STAGE(PG8_SA(1, 0), a3, voffA);
            PG8_WAIT_V(8); PG8_WAIT_L(0); PG8_BAR; PG8_MMA(1, 0, At, B0); PG8_MMA(1, 1, At, B1); PG8_BAR; PG8_SCHED;
            } else {
            PG8_LDB(B0, 0, 0); PG8_SCHED; PG8_LDA(At, 0, 0); PG8_STAGE(PG8_SA(1, 1), a1 + hstep, voffA);
            PG8_WAIT_L(8); PG8_BAR; PG8_WAIT_L(0); PG8_MMA(0, 0, At, B0); PG8_BAR; PG8_SCHED;
            PG8_LDB(B1, 0, 1); PG8_STAGE(PG8_SB(0, 0), b2, voffB);
            PG8_BAR; PG8_WAIT_L(0); PG8_MMA(0, 1, At, B1); PG8_BAR;
            PG8_LDA(At, 0, 1); PG8_STAGE(PG8_SA(0, 0), a2, voffA);
            PG8_BAR; PG8_WAIT_L(0); PG8_MMA(1, 0, At, B0); PG8_BAR; PG8_SCHED;
            PG8_STAGE(PG8_SB(0, 1), b2 + hstep, voffB);
            PG8_WAIT_V(6); PG8_BAR; PG8_MMA(1, 1, At, B1); PG8_BAR;
            PG8_LDB(B0, 1, 0); PG8_SCHED; PG8_LDA(At, 1, 0); PG8_STAGE(PG8_SA(0, 1), a2 + hstep, voffA);
            PG8_WAIT_L(8); PG8_BAR; PG8_WAIT_L(0); PG8_MMA(0, 0, At, B0); PG8_BAR; PG8_SCHED;
            PG8_LDB(B1, 1, 1); PG8_STAGE(PG8_SB(1, 0), b3, voffB);
            PG8_BAR; PG8_WAIT_L(0); PG8_MMA(0, 1, At, B1); PG8_BAR;
            PG8_LDA(At, 1, 1); PG8_STAGE(PG8_SA(1, 0), a3, voffA);
            PG8_BAR; PG8_WAIT_L(0); PG8_MMA(1, 0, At, B0); PG8_BAR; PG8_SCHED;
            PG8_STAGE(PG8_SB(1, 1), b3 + hstep, voffB);
            PG8_WAIT_V(6); PG8_BAR; PG8_MMA(1, 1, At, B1); PG8_BAR;
            }
        }
        if constexpr (ALIGN_EPI) { if (wr == 0) PG8_BAR; }
        if constexpr (!Epi::AFTER_DRAIN) { E(acc, cur, wr, wc, fr, fq); S.done(cur); }
        if (!has_next) break;
#pragma unroll
        for (int a = 0; a < 2; ++a)
#pragma unroll
            for (int b = 0; b < 2; ++b)
#pragma unroll
                for (int m = 0; m < 4; ++m)
#pragma unroll
                    for (int n = 0; n < 2; ++n) acc[a][b][m][n] = (f32x4){0.f, 0.f, 0.f, 0.f};
        cur = nxt; cA = nA; cB = nB; ++ui;
        if constexpr (ALIGN_EPI) { if (wr == 1) PG8_BAR; }
    }
    PG8_WAIT_V(0);
    if constexpr (!ALIGN_EPI) { if (wr == 0) PG8_BAR; }
    PG8_BAR;
    if constexpr (Epi::AFTER_DRAIN) { E.fused(acc, cur, wr, wc, fr, fq, lds, wid, lane); S.done(cur); }
#undef PG8_SA
#undef PG8_SB
#undef PG8_STAGE
#undef PG8_LDA
#undef PG8_LDB
#undef PG8_MMA
#undef PG8_WAIT_V
#undef PG8_WAIT_L
#undef PG8_BAR
#undef PG8_SCHED
}
}

namespace mk {
#define LAS __attribute__((address_space(3)))
typedef unsigned short bf16;
typedef short bf16x8 __attribute__((ext_vector_type(8)));
typedef float f32x4 __attribute__((ext_vector_type(4)));
typedef float f32x16 __attribute__((ext_vector_type(16)));
typedef unsigned u32x4 __attribute__((ext_vector_type(4)));
typedef unsigned u32x2 __attribute__((ext_vector_type(2)));

constexpr int DM = 1024, MLAT = 16384, MCTX = 2048, MALL = 18432, NIN = 2048, FF = 2816, NGU = 5632, SEQ = 2048, CTXL = 256;
constexpr float EPS = 1e-6f, LOG2E = 1.4426950408889634f;
constexpr int NTHREADS = 512, NWAVES = 8;
constexpr int LDS_BYTES = 143360;
constexpr int LDS_ROPE = 131072 + 1024;

constexpr size_t WS_WIN = 0;
constexpr size_t WS_WOUT = WS_WIN + 2ull * NIN * DM * 2;
constexpr size_t WS_WGU = WS_WOUT + 2ull * DM * DM * 2;
constexpr size_t WS_WD = WS_WGU + 2ull * NGU * DM * 2;
constexpr size_t WS_MOD = WS_WD + 2ull * DM * FF * 2;
constexpr size_t WS_ROPE = WS_MOD + 2ull * 9 * 6144 * 4;
constexpr size_t WS_WSBF = WS_ROPE + 8192;
constexpr size_t WS_WPT = WS_WSBF + 2ull * 4 * 128 * 128 * 2;
constexpr size_t WS_XC = WS_WPT + 2ull * 4 * 64 * 64 * 2;
constexpr size_t WS_BAR = WS_XC + (size_t)MCTX * DM * 4;
constexpr size_t WS_GS = WS_BAR + 16384;
constexpr size_t WS_BIAS1 = WS_GS + 2ull * 2 * 9 * 1024 * 4;
constexpr size_t WS_BIAS2 = WS_BIAS1 + 2ull * 9 * NIN * 4;
constexpr size_t WS_SS = WS_BIAS2 + 2ull * 9 * NGU * 4;
constexpr size_t WS_H = WS_SS + 4ull * MALL * 4;
constexpr size_t WS_P = WS_H + (size_t)MALL * DM * 2;
constexpr size_t WS_MIX = WS_P + (size_t)MALL * NIN * 2;
constexpr size_t WS_HID = WS_P;
constexpr size_t WS_PART2 = WS_P;
constexpr size_t WS_PART4 = WS_HID + (size_t)MALL * FF * 2;
constexpr size_t WS_END = WS_PART4 + 8ull * MCTX * DM * 4;
static_assert((size_t)MALL * FF * 2 <= (size_t)MALL * NIN * 2 + (size_t)MALL * DM * 2, "HID overlay");

struct Params { const float* in[24]; float* out; unsigned char* ws; int ph_lo, ph_hi; };
typedef const __attribute__((address_space(4))) Params* KArgPtr;
struct KIn { KArgPtr k; __device__ __forceinline__ const float* operator[](int i) const { return k->in[i]; } };
struct KP { KIn in; float* out; unsigned char* ws; };
__device__ __forceinline__ KP make_kp() { KArgPtr k = (KArgPtr)__builtin_amdgcn_kernarg_segment_ptr(); asm volatile("" : "+s"(k));
    KP p; p.in.k = k; p.out = p.in.k->out; p.ws = p.in.k->ws; return p; }
enum { I_X = 0, I_C, I_CTX, I_CCTX, I_WMOD, I_BMOD, I_GMIX, I_GFFN, I_WIN, I_WOUT, I_AQG, I_AKG, I_ASINK, I_BVG, I_BWS, I_BBS, I_CWP, I_CSC, I_DQG, I_DKG, I_RPB, I_WG, I_WU, I_WDN };

__device__ __forceinline__ unsigned f2bf(float f) { unsigned u = __float_as_uint(f); return (u + 0x7fffu + ((u >> 16) & 1u)) >> 16; }
typedef __bf16 bf16x2_t __attribute__((ext_vector_type(2)));
__device__ __forceinline__ unsigned pk2(float lo, float hi) { bf16x2_t v; v.x = (__bf16)lo; v.y = (__bf16)hi; return __builtin_bit_cast(unsigned, v); }
__device__ __forceinline__ float bflo(unsigned w) { return __uint_as_float(w << 16); }
__device__ __forceinline__ float bfhi(unsigned w) { return __uint_as_float(w & 0xffff0000u); }
__device__ __forceinline__ float wave_sum(float v) {
#pragma unroll
    for (int o = 1; o < 64; o <<= 1) v += __shfl_xor(v, o);
    return v;
}
__device__ __forceinline__ float gelu_tanh(float x) {
    const float u = 0.7978845608028654f * (x + 0.044715f * x * x * x);
    const float t = __builtin_amdgcn_exp2f(u * (2.0f * LOG2E));
    const float th = 1.0f - 2.0f * __builtin_amdgcn_rcpf(t + 1.0f);
    return 0.5f * x * (1.0f + th);
}
__device__ __forceinline__ float silu_f(float x) { return x / (1.0f + __expf(-x)); }
__device__ __forceinline__ f32x16 mfma32(bf16x8 a, bf16x8 b, f32x16 c) { return __builtin_amdgcn_mfma_f32_32x32x16_bf16(a, b, c, 0, 0, 0); }
__device__ __forceinline__ bf16x8 as_bf16x8(u32x4 v) { return __builtin_bit_cast(bf16x8, v); }

template <bool WITH_H>
struct EpiResGate {
    static constexpr bool PERM = true, AFTER_DRAIN = false;
    const float* src; float* dst; const float* gate; bf16* H; float* ss; const float* gs;
    __device__ __forceinline__ void operator()(const pg8::f32x4 (&acc)[2][2][4][2], const pg8::Unit& u, int wr, int wc, int fr, int fq) const {
        const int rbase = u.pm * 256 + wr * 64 + fr;
        const int bb = u.pm >> 3;
        const float* gr = gate + bb * 6144;
        const int col0 = u.pn * 256 + wc * 32 + 8 * fq;
        pg8::f32x4 gv[2][2], sv[2][2];
#pragma unroll
        for (int bj = 0; bj < 2; ++bj)
#pragma unroll
            for (int n = 0; n < 2; ++n) { gv[bj][n] = *(const pg8::f32x4*)(gr + col0 + bj * 128 + n * 4); if (WITH_H) sv[bj][n] = *(const pg8::f32x4*)(gs + bb * 1024 + col0 + bj * 128 + n * 4); }
#pragma unroll
        for (int am = 0; am < 4; ++am) { const int ai = am >> 1, m0 = 2 * (am & 1);
            pg8::f32x4 xpre[4][2][2];
#pragma unroll
            for (int m = m0; m < m0 + 2; ++m) { const size_t off = (size_t)(rbase + ai * 128 + m * 16) * DM + col0;
#pragma unroll
                for (int bj = 0; bj < 2; ++bj)
#pragma unroll
                    for (int n = 0; n < 2; ++n) xpre[m][bj][n] = *(const pg8::f32x4*)(src + off + bj * 128 + n * 4); }
#pragma unroll
            for (int m = m0; m < m0 + 2; ++m) { const int row = rbase + ai * 128 + m * 16; const size_t off = (size_t)row * DM + col0; float q = 0.f;
#pragma unroll
                for (int bj = 0; bj < 2; ++bj) { pg8::f32x4 xn[2];
#pragma unroll
                    for (int n = 0; n < 2; ++n) { const pg8::f32x4 xv = xpre[m][bj][n];
                        xn[n] = xv + gv[bj][n] * acc[ai][bj][m][n];
                        *(pg8::f32x4*)(dst + off + bj * 128 + n * 4) = xn[n];
                        if (WITH_H) q += (xn[n][0] * xn[n][0] + xn[n][1] * xn[n][1]) + (xn[n][2] * xn[n][2] + xn[n][3] * xn[n][3]); }
                    if (WITH_H) { const pg8::f32x4 h0 = xn[0] * sv[bj][0], h1 = xn[1] * sv[bj][1];
                        u32x4 w; w.x = pk2(h0[0], h0[1]); w.y = pk2(h0[2], h0[3]); w.z = pk2(h1[0], h1[1]); w.w = pk2(h1[2], h1[3]); *(u32x4*)(H + off + bj * 128) = w; } }
                if (WITH_H) { q += __shfl_xor(q, 16); q += __shfl_xor(q, 32); if (fq == 0) __hip_atomic_fetch_add(ss + row, q, __ATOMIC_RELAXED, __HIP_MEMORY_SCOPE_AGENT); } } }
    }
};
struct EpiPartial {
    static constexpr bool PERM = false, AFTER_DRAIN = false;
    float* dst; int slot0;
    __device__ __forceinline__ void operator()(const pg8::f32x4 (&acc)[2][2][4][2], const pg8::Unit& u, int wr, int wc, int fr, int fq) const {
        const int rbase = u.pm * 256 + wr * 64 + fr, col0 = u.pn * 256 + wc * 32 + 4 * fq;
        float* base = dst + (size_t)(slot0 + u.pk) * MCTX * DM;
#pragma unroll
        for (int ai = 0; ai < 2; ++ai)
#pragma unroll
            for (int m = 0; m < 4; ++m) { float* d = base + (size_t)(rbase + ai * 128 + m * 16) * DM + col0;
#pragma unroll
                for (int bj = 0; bj < 2; ++bj)
#pragma unroll
                    for (int n = 0; n < 2; ++n) *(pg8::f32x4*)(d + bj * 128 + n * 16) = acc[ai][bj][m][n]; }
    }
};
struct SplitKOrder {
    int nsplit, nN, nunits, G, c;
    __device__ void init(int nM, int nN_, int nsplit_, int G_, int c_, int rot) { nsplit = nsplit_; nN = nN_; nunits = nM * nN_ * nsplit_; G = G_; c = (c_ + G_ - rot) % G_; }
    __device__ bool next(int i, pg8::Unit& u) const { const int L = i * G + c; if (L >= nunits) return false; const int tile = L / nsplit; u.pk = L - tile * nsplit; u.pm = tile / nN; u.pn = tile - u.pm * nN; return true; }
    __device__ __forceinline__ void a_ready(const pg8::Unit&) const {}
    __device__ __forceinline__ void done(const pg8::Unit&) const {}
};
__device__ __forceinline__ float row_rstd(const float* ss, int row) { return 1.0f / sqrtf(ss[row] * (1.0f / DM) + EPS); }
struct EpiG1 {
    static constexpr bool PERM = true, AFTER_DRAIN = false;
    bf16* O; const float* ss; const float* bias; const float* aqg; const float* akg; const float* dqg; const float* dkg; const LAS float* rope;
    __device__ __forceinline__ void operator()(const pg8::f32x4 (&acc)[2][2][4][2], const pg8::Unit& u, int wr, int wc, int fr, int fq) const {
        const bool lat = u.pm < (MLAT / 256);
        const int bb = lat ? (u.pm >> 3) : 8;
        const int row0 = u.pm * 256 + wr * 64 + fr;
        const float* br = bias + bb * NIN + u.pn * 256 + wc * 32 + 8 * fq;
        const int colL = u.pn * 256 + 64 * wc + 8 * fq;
        const float* gain = nullptr; float qs = 1.0f; int mode = 0;
        if (u.pn == 0) { gain = aqg; qs = 0.125f * LOG2E; mode = 2; }
        else if (u.pn == 1 && wc < 2) { gain = akg; mode = 2; }
        else if (u.pn == 5) { gain = dqg; qs = 0.125f * LOG2E; mode = 1; }
        else if (u.pn == 6) { gain = dkg; mode = 1; }
        if (mode == 2 && !lat) mode = 1;
        pg8::f32x4 bv[2][2], gn[2][2];
#pragma unroll
        for (int bj = 0; bj < 2; ++bj)
#pragma unroll
            for (int n = 0; n < 2; ++n) { bv[bj][n] = *(const pg8::f32x4*)(br + bj * 128 + 4 * n); gn[bj][n] = mode ? *(const pg8::f32x4*)(gain + 32 * bj + 8 * fq + 4 * n) : (pg8::f32x4){1.f, 1.f, 1.f, 1.f}; }
        const float sgn = fq < 2 ? -1.0f : 1.0f;
        float rsv[2][4];
#pragma unroll
        for (int ai = 0; ai < 2; ++ai)
#pragma unroll
            for (int m = 0; m < 4; ++m) rsv[ai][m] = ss[row0 + ai * 128 + m * 16];
#pragma unroll
        for (int ai = 0; ai < 2; ++ai)
#pragma unroll
            for (int m = 0; m < 4; ++m) { const int row = row0 + ai * 128 + m * 16; const float rs = __builtin_amdgcn_rsqf(rsv[ai][m] * (1.0f / DM) + EPS);
                pg8::f32x4 v[2][2];
#pragma unroll
                for (int bj = 0; bj < 2; ++bj)
#pragma unroll
                    for (int n = 0; n < 2; ++n) v[bj][n] = acc[ai][bj][m][n] * rs + bv[bj][n];
                if (mode) {
                    float q = 0.f;
#pragma unroll
                    for (int bj = 0; bj < 2; ++bj)
#pragma unroll
                        for (int n = 0; n < 2; ++n) q += (v[bj][n][0] * v[bj][n][0] + v[bj][n][1] * v[bj][n][1]) + (v[bj][n][2] * v[bj][n][2] + v[bj][n][3] * v[bj][n][3]);
                    q += __shfl_xor(q, 16); q += __shfl_xor(q, 32);
                    const float hr = __builtin_amdgcn_rsqf(q * (1.0f / 64.0f) + EPS) * qs;
#pragma unroll
                    for (int bj = 0; bj < 2; ++bj)
#pragma unroll
                        for (int n = 0; n < 2; ++n) v[bj][n] = v[bj][n] * hr * gn[bj][n];
                    if (mode == 2) {
                        const int pos = row & (SEQ - 1);
#pragma unroll
                        for (int bj = 0; bj < 2; ++bj) { const int pp = bj ? (pos & 63) : (pos >> 6);
#pragma unroll
                            for (int n = 0; n < 2; ++n) { const LAS float* tb = rope + (pp * 16 + 8 * (fq & 1) + 4 * n) * 2;
                                const pg8::f32x4 cs0 = *(const LAS pg8::f32x4*)(tb), cs1 = *(const LAS pg8::f32x4*)(tb + 4);
                                const float co[4] = {cs0[0], cs0[2], cs1[0], cs1[2]}, sn[4] = {cs0[1], cs0[3], cs1[1], cs1[3]};
#pragma unroll
                                for (int j = 0; j < 4; ++j) { const float own = v[bj][n][j]; const float oth = __shfl_xor(own, 32); v[bj][n][j] = own * co[j] + sgn * oth * sn[j]; } } }
                    }
                }
#pragma unroll
                for (int bj = 0; bj < 2; ++bj) { u32x4 w; w.x = pk2(v[bj][0][0], v[bj][0][1]); w.y = pk2(v[bj][0][2], v[bj][0][3]); w.z = pk2(v[bj][1][0], v[bj][1][1]); w.w = pk2(v[bj][1][2], v[bj][1][3]);
                    *(u32x4*)(O + (size_t)row * NIN + colL + 32 * bj) = w; } }
    }
};
struct EpiSwiglu {
    static constexpr bool PERM = true, AFTER_DRAIN = false;
    bf16* O; const float* ss; const float* bias;
    __device__ __forceinline__ void operator()(const pg8::f32x4 (&acc)[2][2][4][2], const pg8::Unit& u, int wr, int wc, int fr, int fq) const {
        const int bb = u.pm >= (MLAT / 256) ? 8 : (u.pm >> 3);
        const int row0 = u.pm * 256 + wr * 64 + fr, col0 = u.pn * 128 + wc * 32 + 8 * fq;
        const float* br = bias + bb * NGU + u.pn * 256 + wc * 32 + 8 * fq;
        pg8::f32x4 bg[2], bu[2];
#pragma unroll
        for (int n = 0; n < 2; ++n) { bg[n] = *(const pg8::f32x4*)(br + 4 * n); bu[n] = *(const pg8::f32x4*)(br + 128 + 4 * n); }
        float rsv[2][4];
#pragma unroll
        for (int ai = 0; ai < 2; ++ai)
#pragma unroll
            for (int m = 0; m < 4; ++m) rsv[ai][m] = ss[row0 + ai * 128 + m * 16];
#pragma unroll
        for (int ai = 0; ai < 2; ++ai)
#pragma unroll
            for (int m = 0; m < 4; ++m) { const int row = row0 + ai * 128 + m * 16; const float rs = __builtin_amdgcn_rsqf(rsv[ai][m] * (1.0f / DM) + EPS);
                float hv[8];
#pragma unroll
                for (int n = 0; n < 2; ++n)
#pragma unroll
                    for (int j = 0; j < 4; ++j) { const float g = acc[ai][0][m][n][j] * rs + bg[n][j], up = acc[ai][1][m][n][j] * rs + bu[n][j]; hv[4 * n + j] = g * __builtin_amdgcn_rcpf(1.0f + __builtin_amdgcn_exp2f(-g * LOG2E)) * up; }
                u32x4 w; w.x = pk2(hv[0], hv[1]); w.y = pk2(hv[2], hv[3]); w.z = pk2(hv[4], hv[5]); w.w = pk2(hv[6], hv[7]);
                *(u32x4*)(O + (size_t)row * FF + col0) = w; }
    }
};

typedef unsigned gu32;
#define XB_TMO      128
#define XB_XCNT(j)  (256  + 64 * (j))
#define XB_XSUB(j)  (1280 + 64 * (j))
#define XB_XGEN(j)  (2304 + 64 * (j))
#define XB_TOP      3328
#define XB_TOPGEN   3392
#define XCD_BAR_WORDS 3456
#define XB_SPIN_CAP (1u << 18)

__device__ __forceinline__ unsigned xb_ld(unsigned* p)              { return __hip_atomic_load(p, __ATOMIC_RELAXED, __HIP_MEMORY_SCOPE_AGENT); }
__device__ __forceinline__ unsigned xb_add(unsigned* p, unsigned v) { return __hip_atomic_fetch_add(p, v, __ATOMIC_RELAXED, __HIP_MEMORY_SCOPE_AGENT); }
__device__ __forceinline__ unsigned xb_xcc_id() { return (unsigned)__builtin_amdgcn_s_getreg((3 << 11) | 20) & 0xFu; }
#define XB_SPIN(cond, bar) do { unsigned _sp = 0; while (cond) { __builtin_amdgcn_s_sleep(1); \
    if ((++_sp & 255u) == 0u) { if (xb_ld(&(bar)[XB_TMO])) break; if (_sp > XB_SPIN_CAP) { atomicAdd(&(bar)[XB_TMO], 1u); break; } } } } while (0)

struct XcdBarrier {
    unsigned* bar; unsigned x;
    volatile LAS unsigned* st;
};

__device__ __forceinline__ XcdBarrier xcd_barrier_post(unsigned* bar, volatile LAS unsigned* st) {
    XcdBarrier b; b.bar = bar; b.x = xb_xcc_id(); b.st = st;
    if (threadIdx.x == 0) (void)xb_add(&bar[XB_XCNT(b.x)], 1u);
    return b;
}
__device__ __forceinline__ void xcd_barrier_complete(unsigned* bar, unsigned x, unsigned& nloc, unsigned& nx) {
    const unsigned G = gridDim.x * gridDim.y * gridDim.z;
    unsigned sum, cnt, mine, sp = 0u;
    for (;;) {
        sum = 0u; cnt = 0u; mine = 0u;
#pragma unroll
        for (unsigned j = 0; j < 16; ++j) { const unsigned c = xb_ld(&bar[XB_XCNT(j)]); sum += c; cnt += (c > 0u) ? 1u : 0u; mine = (j == x) ? c : mine; }
        if (sum == G) break;
        __builtin_amdgcn_s_sleep(1);
        if ((++sp & 255u) == 0u) { if (xb_ld(&bar[XB_TMO])) break; if (sp > XB_SPIN_CAP) { atomicAdd(&bar[XB_TMO], 1u); break; } }
    }
    nloc = mine > 0u ? mine : 1u; nx = cnt > 0u ? cnt : 1u;
}

__device__ __forceinline__ void xcd_barrier(const XcdBarrier& b) {
    asm volatile("s_waitcnt vmcnt(0)" ::: "memory");
    __syncthreads();
    if (threadIdx.x == 0) {
        unsigned* bar = b.bar;
        __builtin_amdgcn_s_waitcnt(0);
        unsigned nloc = b.st[0], nx = b.st[1];
        if (nloc == 0u) { xcd_barrier_complete(bar, b.x, nloc, nx); b.st[0] = nloc; b.st[1] = nx; }
        const unsigned old = xb_add(&bar[XB_XSUB(b.x)], 1u);
        const unsigned gen = old / nloc;
        if (old + 1u == (gen + 1u) * nloc) {
            __builtin_amdgcn_fence(__ATOMIC_RELEASE, "agent");
            asm volatile("s_waitcnt vmcnt(0)" ::: "memory");
            const unsigned og = xb_add(&bar[XB_TOP], 1u);
            const unsigned tg = og / nx;
            if (og + 1u == (tg + 1u) * nx) xb_add(&bar[XB_TOPGEN], 1u);
            else XB_SPIN(xb_ld(&bar[XB_TOPGEN]) == tg, bar);
            __builtin_amdgcn_fence(__ATOMIC_ACQUIRE, "agent");
            xb_add(&bar[XB_XGEN(b.x)], 1u);
            asm volatile("s_waitcnt vmcnt(0)" ::: "memory");
        } else {
            XB_SPIN(xb_ld(&bar[XB_XGEN(b.x)]) == gen, bar);
            __builtin_amdgcn_fence(__ATOMIC_ACQUIRE, "agent");
            asm volatile("s_waitcnt vmcnt(0)" ::: "memory");
        }
    }
    __syncthreads();
}
__device__ __forceinline__ void transpose_item(const float* W, int K, int N, bf16* WT, int k0, int n0, int drow, float* scr, int lane) {
    float tv[32];
#pragma unroll
    for (int i = 0; i < 32; ++i) tv[i] = W[(size_t)(k0 + 2 * i + (lane >> 5)) * N + n0 + (lane & 31)];
#pragma unroll
    for (int i = 0; i < 32; ++i) scr[(2 * i + (lane >> 5)) * 33 + (lane & 31)] = tv[i];
    asm volatile("s_waitcnt lgkmcnt(0)" ::: "memory");
    const int c = lane & 7;
#pragma unroll
    for (int j = 0; j < 4; ++j) { const int n = (lane >> 3) + 8 * j; const float* s = scr + (8 * c) * 33 + n;
        u32x4 o; o.x = pk2(s[0 * 33], s[1 * 33]); o.y = pk2(s[2 * 33], s[3 * 33]); o.z = pk2(s[4 * 33], s[5 * 33]); o.w = pk2(s[6 * 33], s[7 * 33]);
        *(u32x4*)(WT + (size_t)(drow + n) * K + k0 + 8 * c) = o; }
    asm volatile("s_waitcnt lgkmcnt(0)" ::: "memory");
}

__device__ __forceinline__ void phase_transposes(const KP& p, unsigned char* lds, int part, int first_blk, int nblk) {
    const int lane = threadIdx.x & 63, wave = threadIdx.x >> 6;
    unsigned char* ws = p.ws;
    float* scr = (float*)(lds + wave * 16384);
    if ((int)blockIdx.x < first_blk) return;
    const int gw = ((int)blockIdx.x - first_blk) * NWAVES + wave, NGW = nblk * NWAVES;
    if (part == 0) {
        for (int it = gw; it < 2 * 1024; it += NGW) { const int l = it >> 10, r = it & 1023; const int kb = r >> 6, nb = r & 63;
            transpose_item(p.in[I_WIN] + (size_t)l * DM * NIN, DM, NIN, (bf16*)(ws + WS_WIN) + (size_t)l * NIN * DM, 64 * kb, 32 * nb, 256 * (nb >> 3) + 128 * (nb & 1) + 32 * ((nb >> 1) & 3), scr, lane); }
        return;
    }
    for (int it = gw; it < 2 * 4736; it += NGW) {
        const int l = it / 4736; int r = it % 4736;
        if (r < 512) { const int kb = r >> 5, nb = r & 31; transpose_item(p.in[I_WOUT] + (size_t)l * DM * DM, DM, DM, (bf16*)(ws + WS_WOUT) + (size_t)l * DM * DM, 64 * kb, 32 * nb, 32 * nb, scr, lane); continue; } r -= 512;
        if (r < 1408) { const int kb = r / 88, nb = r % 88, n0 = 32 * nb; transpose_item(p.in[I_WG] + (size_t)l * DM * FF, DM, FF, (bf16*)(ws + WS_WGU) + (size_t)l * NGU * DM, 64 * kb, n0, 256 * (n0 >> 7) + (n0 & 127), scr, lane); continue; } r -= 1408;
        if (r < 1408) { const int kb = r / 88, nb = r % 88, n0 = 32 * nb; transpose_item(p.in[I_WU] + (size_t)l * DM * FF, DM, FF, (bf16*)(ws + WS_WGU) + (size_t)l * NGU * DM, 64 * kb, n0, 256 * (n0 >> 7) + 128 + (n0 & 127), scr, lane); continue; } r -= 1408;
        { const int kb = r >> 5, nb = r & 31; transpose_item(p.in[I_WDN] + (size_t)l * FF * DM, FF, DM, (bf16*)(ws + WS_WD) + (size_t)l * DM * FF, 64 * kb, 32 * nb, 32 * nb, scr, lane); }
    }
}
__device__ __forceinline__ void phase_prologue(const KP& p, unsigned char* lds) {
    const int tid = threadIdx.x, lane = tid & 63, wave = tid >> 6;
    unsigned char* ws = p.ws;
    if (blockIdx.x < 192) {
        const int l = blockIdx.x / 96, c0 = 64 * (blockIdx.x % 96);
        float* act = (float*)lds;
        for (int i = tid; i < 9 * 1024; i += NTHREADS) { const int bb = i >> 10, k = i & 1023; const float v = bb < 8 ? p.in[I_C][bb * 1024 + k] : p.in[I_CCTX][k]; act[i] = v / (1.0f + expf(-v)); }
        __syncthreads();
        const float* w = p.in[I_WMOD] + (size_t)l * 1024 * 6144 + c0 + lane;
        float acc[9];
#pragma unroll
        for (int b = 0; b < 9; ++b) acc[b] = 0.f;
        const int kbeg = wave * 128;
#pragma unroll 32
        for (int k = kbeg; k < kbeg + 128; ++k) { const float wv = w[(size_t)k * 6144];
#pragma unroll
            for (int b = 0; b < 9; ++b) acc[b] += act[b * 1024 + k] * wv; }
        float* red = (float*)(lds + 40960);
#pragma unroll
        for (int b = 0; b < 9; ++b) red[(wave * 9 + b) * 64 + lane] = acc[b];
        __syncthreads();
        float* mod = (float*)(ws + WS_MOD);
        for (int i = tid; i < 576; i += NTHREADS) { const int b = i >> 6, cc = i & 63; float s = p.in[I_BMOD][l * 6144 + c0 + cc];
#pragma unroll
            for (int wv = 0; wv < 8; ++wv) s += red[(wv * 9 + b) * 64 + cc];
            mod[(size_t)(l * 9 + b) * 6144 + c0 + cc] = s; }
        __syncthreads();
    } else {
        const int g = (blockIdx.x - 192) * NTHREADS + tid;
        if (g < 1024) { const int pos = g >> 4, f = g & 15; const float inv = powf(10000.0f, -(float)f / 16.0f); const float ang = (float)pos * inv;
            float* rope = (float*)(ws + WS_ROPE); rope[2 * g] = cosf(ang); rope[2 * g + 1] = sinf(ang); }
        bf16* wsbf = (bf16*)(ws + WS_WSBF);
        for (int i = g; i < 2 * 4 * 128 * 128; i += 32768) wsbf[i] = (bf16)f2bf(p.in[I_BWS][i]);
        bf16* wpt = (bf16*)(ws + WS_WPT);
        { const int i = g; const int lg = i >> 12, rem = i & 4095, d = rem >> 6, c = rem & 63; wpt[i] = (bf16)f2bf(p.in[I_CWP][lg * 4096 + c * 64 + d]); }
    }
    {
        const int gid = blockIdx.x * NTHREADS + tid, GT = gridDim.x * NTHREADS;
        float* ssz = (float*)(ws + WS_SS); for (int i = gid; i < 4 * MALL; i += GT) ssz[i] = 0.f;
        const f32x4* cs = (const f32x4*)p.in[I_CTX]; f32x4* xc = (f32x4*)(ws + WS_XC); for (int i = gid; i < MCTX * DM / 4; i += GT) xc[i] = cs[i];
    }
    phase_transposes(p, lds, 0, 0, gridDim.x);
}

__device__ __forceinline__ void phase_norm(const KP& p, int l, int which, const float* src_lat, const float* src_ctx, int row_lo, int row_hi, float* ss) {
    const int lane = threadIdx.x & 63, wave = threadIdx.x >> 6;
    const int gw = blockIdx.x * NWAVES + wave, NGW = gridDim.x * NWAVES;
    const float* mod = (const float*)(p.ws + WS_MOD);
    const float* g = (which ? p.in[I_GFFN] : p.in[I_GMIX]) + l * DM;
    bf16* H = (bf16*)(p.ws + WS_H);
    f32x4 vn[4];
    {   const int row = row_lo + gw;
        if (row < row_hi) { const float* xr = row >= MLAT ? src_ctx + (size_t)(row - MLAT) * DM : src_lat + (size_t)row * DM;
#pragma unroll
            for (int j = 0; j < 4; ++j) vn[j] = *(const f32x4*)(xr + 4 * lane + 256 * j); } }
    for (int row = row_lo + gw; row < row_hi; row += NGW) {
        const bool isc = row >= MLAT;
        const int bb = isc ? 8 : (row >> 11);
        const float* sc = mod + (size_t)(l * 9 + bb) * 6144 + (which ? 4096 : 1024);
        f32x4 v[4]; float q = 0.f;
#pragma unroll
        for (int j = 0; j < 4; ++j) v[j] = vn[j];
        {   const int rn = row + NGW;
            if (rn < row_hi) { const float* xr = rn >= MLAT ? src_ctx + (size_t)(rn - MLAT) * DM : src_lat + (size_t)rn * DM;
#pragma unroll
                for (int j = 0; j < 4; ++j) vn[j] = *(const f32x4*)(xr + 4 * lane + 256 * j); } }
#pragma unroll
        for (int j = 0; j < 4; ++j) q += (v[j].x * v[j].x + v[j].y * v[j].y) + (v[j].z * v[j].z + v[j].w * v[j].w);
        q = wave_sum(q);
        if (lane == 0) ss[row] = q;
#pragma unroll
        for (int j = 0; j < 4; ++j) { const int col = 4 * lane + 256 * j;
            const f32x4 gg = *(const f32x4*)(g + col), sv = *(const f32x4*)(sc + col);
            const f32x4 y = v[j] * gg * (sv + 1.0f);
            u32x2 w; w.x = pk2(y.x, y.y); w.y = pk2(y.z, y.w);
            *(u32x2*)(H + (size_t)row * DM + col) = w; }
    }
}
__device__ __forceinline__ void phase_norm_ctx(const KP& p, int l, int which, int lg, int goff, const float* part, float* ss) {
    const int lane = threadIdx.x & 63, wave = threadIdx.x >> 6;
    const int gw = blockIdx.x * NWAVES + wave, NGW = gridDim.x * NWAVES;
    const float* mod = (const float*)(p.ws + WS_MOD);
    const float* g = (which ? p.in[I_GFFN] : p.in[I_GMIX]) + l * DM;
    const float* sc = mod + (size_t)(l * 9 + 8) * 6144 + (which ? 4096 : 1024);
    const float* gate = mod + (size_t)(lg * 9 + 8) * 6144 + goff;
    bf16* H = (bf16*)(p.ws + WS_H); float* XC = (float*)(p.ws + WS_XC);
    for (int r = gw; r < MCTX; r += NGW) {
        f32x4 v[4]; float q = 0.f;
#pragma unroll
        for (int j = 0; j < 4; ++j) { const size_t off = (size_t)r * DM + 4 * lane + 256 * j; f32x4 a = *(const f32x4*)(part + off);
#pragma unroll
            for (int sl = 1; sl < 8; ++sl) a += *(const f32x4*)(part + (size_t)sl * MCTX * DM + off);
            v[j] = *(const f32x4*)(XC + off) + *(const f32x4*)(gate + 4 * lane + 256 * j) * a;
            *(f32x4*)(XC + off) = v[j];
            q += (v[j].x * v[j].x + v[j].y * v[j].y) + (v[j].z * v[j].z + v[j].w * v[j].w); }
        q = wave_sum(q);
        if (lane == 0) ss[MLAT + r] = q;
#pragma unroll
        for (int j = 0; j < 4; ++j) { const int col = 4 * lane + 256 * j;
            const f32x4 gg = *(const f32x4*)(g + col), sv = *(const f32x4*)(sc + col);
            const f32x4 y = v[j] * gg * (sv + 1.0f);
            u32x2 w; w.x = pk2(y.x, y.y); w.y = pk2(y.z, y.w);
            *(u32x2*)(H + (size_t)(MLAT + r) * DM + col) = w; }
    }
}
__device__ __forceinline__ void phase_tables(const KP& p, unsigned char* lds, int sel) {
    const int tid = threadIdx.x, lane = tid & 63, wave = tid >> 6;
    const int gw = blockIdx.x * NWAVES + wave, NGW = gridDim.x * NWAVES;
    const float* mod = (const float*)(p.ws + WS_MOD);
    float* gs = (float*)(p.ws + WS_GS);
    if (sel == 0) for (int i = blockIdx.x * NTHREADS + tid; i < 2 * 2 * 9 * 1024; i += gridDim.x * NTHREADS) { const int lw = i / 9216, rem = i - lw * 9216, bb = rem >> 10, col = rem & 1023, l = lw >> 1, which = lw & 1;
        const float g = (which ? p.in[I_GFFN] : p.in[I_GMIX])[l * DM + col]; gs[i] = g * (1.0f + mod[(size_t)(l * 9 + bb) * 6144 + (which ? 4096 : 1024) + col]); }
    const int ntask = sel ? 176 : 64;
    for (int task = blockIdx.x; task < ntask; task += gridDim.x) {
        const int which = sel, l = sel ? task / 88 : task / 32, slab = sel ? task - l * 88 : task - l * 32;
        float* sh = (float*)lds;
        __syncthreads();
        for (int i = tid; i < 9 * 1024; i += NTHREADS) sh[i] = mod[(size_t)(l * 9 + (i >> 10)) * 6144 + (which ? 3072 : 0) + (i & 1023)];
        __syncthreads();
        const int Nn = which ? NGU : NIN, n = slab * 64 + lane;
        const bf16* WT = (which ? (const bf16*)(p.ws + WS_WGU) + (size_t)l * NGU * DM : (const bf16*)(p.ws + WS_WIN) + (size_t)l * NIN * DM) + (size_t)n * DM + wave * 128;
        float acc[9];
#pragma unroll
        for (int b = 0; b < 9; ++b) acc[b] = 0.f;
        u32x4 wr[16];
#pragma unroll
        for (int i = 0; i < 16; ++i) wr[i] = *(const u32x4*)(WT + 8 * i);
#pragma unroll
        for (int i = 0; i < 16; ++i) { float wf[8]; wf[0] = bflo(wr[i].x); wf[1] = bfhi(wr[i].x); wf[2] = bflo(wr[i].y); wf[3] = bfhi(wr[i].y); wf[4] = bflo(wr[i].z); wf[5] = bfhi(wr[i].z); wf[6] = bflo(wr[i].w); wf[7] = bfhi(wr[i].w);
#pragma unroll
            for (int b = 0; b < 9; ++b) { const float* sr = sh + b * 1024 + wave * 128 + 8 * i; const f32x4 a0 = *(const f32x4*)(sr), a1 = *(const f32x4*)(sr + 4);
#pragma unroll
                for (int j = 0; j < 4; ++j) acc[b] += wf[j] * a0[j] + wf[4 + j] * a1[j]; } }
        float* red = (float*)(lds + 40960);
#pragma unroll
        for (int b = 0; b < 9; ++b) red[(wave * 9 + b) * 64 + lane] = acc[b];
        __syncthreads();
        float* out = which ? (float*)(p.ws + WS_BIAS2) + (size_t)l * 9 * NGU : (float*)(p.ws + WS_BIAS1) + (size_t)l * 9 * NIN;
        for (int i = tid; i < 576; i += NTHREADS) { const int b = i >> 6, cc = i & 63; float a = 0.f;
#pragma unroll
            for (int wv = 0; wv < 8; ++wv) a += red[(wv * 9 + b) * 64 + cc];
            out[(size_t)b * Nn + slab * 64 + cc] = a; }
    }
    __syncthreads();
}

__device__ __forceinline__ void phase_bias2_f32(const KP& p, unsigned char* lds, int first_blk, int nblk) {
    if ((int)blockIdx.x < first_blk) return;
    const int tid = threadIdx.x, lane = tid & 63, wave = tid >> 6;
    const float* mod = (const float*)(p.ws + WS_MOD);
    for (int task = (int)blockIdx.x - first_blk; task < 176; task += nblk) {
        const int l = task / 88, tr = task - l * 88, isup = tr >= 44 ? 1 : 0, slab = isup ? tr - 44 : tr;
        float* sh = (float*)lds;
        __syncthreads();
        for (int i = tid; i < 9 * 1024; i += NTHREADS) sh[i] = mod[(size_t)(l * 9 + (i >> 10)) * 6144 + 3072 + (i & 1023)];
        __syncthreads();
        const float* w = (isup ? p.in[I_WU] : p.in[I_WG]) + (size_t)l * DM * FF + 64 * slab + lane;
        float acc[9];
#pragma unroll
        for (int b = 0; b < 9; ++b) acc[b] = 0.f;
        const int kbeg = wave * 128;
#pragma unroll 32
        for (int k = kbeg; k < kbeg + 128; ++k) { const float wv = w[(size_t)k * FF];
#pragma unroll
            for (int b = 0; b < 9; ++b) acc[b] += sh[b * 1024 + k] * wv; }
        float* red = (float*)(lds + 40960);
#pragma unroll
        for (int b = 0; b < 9; ++b) red[(wave * 9 + b) * 64 + lane] = acc[b];
        __syncthreads();
        float* out = (float*)(p.ws + WS_BIAS2) + (size_t)l * 9 * NGU;
        const int prow0 = 256 * (slab >> 1) + 64 * (slab & 1) + 128 * isup;
        for (int i = tid; i < 576; i += NTHREADS) { const int b = i >> 6, cc = i & 63; float a = 0.f;
#pragma unroll
            for (int wv = 0; wv < 8; ++wv) a += red[(wv * 9 + b) * 64 + cc];
            out[(size_t)b * NGU + prow0 + cc] = a; }
    }
    __syncthreads();
}

__device__ __forceinline__ void prep_head(const u32x4 (&raw)[4], const float* gainL, const float* ropeL, int pos, float scale, int h, u32x4 (&out)[4]) {
    float x[4][8]; float ss = 0.f;
#pragma unroll
    for (int c = 0; c < 4; ++c) { x[c][0] = bflo(raw[c].x); x[c][1] = bfhi(raw[c].x); x[c][2] = bflo(raw[c].y); x[c][3] = bfhi(raw[c].y); x[c][4] = bflo(raw[c].z); x[c][5] = bfhi(raw[c].z); x[c][6] = bflo(raw[c].w); x[c][7] = bfhi(raw[c].w);
#pragma unroll
        for (int i = 0; i < 8; ++i) ss += x[c][i] * x[c][i]; }
    ss += __shfl_xor(ss, 32);
    const float rstd = (1.0f / sqrtf(ss * (1.0f / 64.0f) + EPS)) * scale;
#pragma unroll
    for (int c = 0; c < 4; ++c) { const f32x4 g0 = *(const f32x4*)(gainL + 16 * c + 8 * h), g1 = *(const f32x4*)(gainL + 16 * c + 8 * h + 4);
#pragma unroll
        for (int i = 0; i < 4; ++i) { x[c][i] *= rstd * g0[i]; x[c][4 + i] *= rstd * g1[i]; } }
    if (pos >= 0) {
        const int pr = pos >> 6, pc = pos & 63;
#pragma unroll
        for (int ax = 0; ax < 2; ++ax) { const float* tb = ropeL + ((ax ? pc : pr) * 16 + 8 * h) * 2;
#pragma unroll
            for (int i4 = 0; i4 < 4; ++i4) { const f32x4 cs = *(const f32x4*)(tb + 4 * i4);
#pragma unroll
                for (int e = 0; e < 2; ++e) { const int i = 2 * i4 + e; const float co = cs[2 * e], sn = cs[2 * e + 1]; const float a = x[2 * ax][i], b = x[2 * ax + 1][i];
                    x[2 * ax][i] = a * co - b * sn; x[2 * ax + 1][i] = a * sn + b * co; } } }
    }
#pragma unroll
    for (int c = 0; c < 4; ++c) { out[c].x = pk2(x[c][0], x[c][1]); out[c].y = pk2(x[c][2], x[c][3]); out[c].z = pk2(x[c][4], x[c][5]); out[c].w = pk2(x[c][6], x[c][7]); }
}
__device__ __forceinline__ void phase_prep(const KP& p, int l) {
    const int lane = threadIdx.x & 63, wave = threadIdx.x >> 6, ql = lane & 31, h = lane >> 5;
    const int gw = blockIdx.x * NWAVES + wave, NGW = gridDim.x * NWAVES;
    bf16* P = (bf16*)(p.ws + WS_P); const float* rope = (const float*)(p.ws + WS_ROPE);
    for (int it = gw; it < (MALL / 32) * 14; it += NGW) {
        const int rb = it / 14, slot = it % 14; const int row = rb * 32 + ql;
        int col; const float* gain; bool isq, ropeok;
        if (slot < 4) { col = 64 * slot; gain = p.in[I_AQG] + l * 64; isq = true; ropeok = true; }
        else if (slot < 6) { col = 256 + 64 * (slot - 4); gain = p.in[I_AKG] + l * 64; isq = false; ropeok = true; }
        else if (slot < 10) { col = 1280 + 64 * (slot - 6); gain = p.in[I_DQG] + l * 64; isq = true; ropeok = false; }
        else { col = 1536 + 64 * (slot - 10); gain = p.in[I_DKG] + l * 64; isq = false; ropeok = false; }
        const int pos = (ropeok && row < MLAT) ? (row & (SEQ - 1)) : -1;
        bf16* ptr = P + (size_t)row * NIN + col + 8 * h;
        u32x4 raw[4], o[4];
#pragma unroll
        for (int c = 0; c < 4; ++c) raw[c] = *(const u32x4*)(ptr + 16 * c);
        prep_head(raw, gain, rope, pos, isq ? 0.125f * LOG2E : 1.0f, h, o);
#pragma unroll
        for (int c = 0; c < 4; ++c) *(u32x4*)(ptr + 16 * c) = o[c];
    }
}

constexpr int A_KB = 0, A_KB_SZ = 64 * 144, A_VB = 2 * A_KB_SZ, A_VB_SZ = 64 * 144, A_RPB = A_VB + 2 * A_VB_SZ, A_TAB = A_RPB + 2048, A_END = A_TAB + 256 * 144;

template <int TYPE>
__device__ __forceinline__ void attn_unit(const KP& p, unsigned char* lds, int l, int uidx) {
    int tid_ = threadIdx.x; asm volatile("" : "+v"(tid_));
    const int tid = tid_, lane = tid & 63, wave = __builtin_amdgcn_readfirstlane(tid >> 6), ql = lane & 31, h = lane >> 5;
    const bf16* P = (const bf16*)(p.ws + WS_P); bf16* MIX = (bf16*)(p.ws + WS_MIX);
    int b, qcol, kcol, vcol, ocol, qrow, qpos = 0, NT = 4; float m_i = -1e30f, l_i = 0.f;
    int n = 0, t_lo = 0, wq = 0;
    int hd = 0, c0 = 0, kr_lo = 0, qr = 0, qc = 0, rs_q = 0, cs_q = 0, rsa = 0, rsb = 0, cbq = 0;
    if (TYPE == 0) {
        b = uidx >> 5; const int kh = (uidx >> 4) & 1; n = uidx & 15; const int gi = wave >> 2; wq = wave & 3; const int hq = 2 * kh + gi;
        qpos = n * 128 + 32 * wq + ql; qrow = b * SEQ + qpos; qcol = 64 * hq; kcol = 256 + 64 * kh; vcol = 384 + 64 * kh; ocol = 64 * hq;
        t_lo = (n == 0) ? 2 : 0; const int t_hi = (n == 15) ? 4 : 6; NT = 4 + t_hi - t_lo;
        m_i = p.in[I_ASINK][l * 4 + hq] * LOG2E; l_i = h == 0 ? 1.0f : 0.0f;
    } else if (TYPE == 1) {
        b = uidx >> 5; hd = (uidx >> 3) & 3; const int cb = (uidx >> 1) & 3, rh = uidx & 1; const int ra = 16 * rh + 2 * wave; cbq = cb;
        qr = ra + (ql >> 4); qc = 16 * cb + (ql & 15); qpos = qr * 64 + qc; qrow = b * SEQ + qpos;
        qcol = 1280 + 64 * hd; kcol = 1536 + 64 * hd; vcol = 1792 + 64 * hd; ocol = 768 + 64 * hd;
        c0 = cb == 0 ? 0 : (cb == 1 ? 8 : (cb == 2 ? 24 : 32)); kr_lo = rh ? 12 : 0; NT = 4 + 10;
        rs_q = min(max(qr - 4, 0), 24); cs_q = min(max(qc - 8, 0), 48); rsa = min(max(ra - 4, 0), 24); rsb = min(max(ra - 3, 0), 24);
    } else {
        if (uidx < 32) { b = uidx >> 2; const int kh = (uidx >> 1) & 1, gi = uidx & 1, hq = 2 * kh + gi; qcol = 64 * hq; kcol = 256 + 64 * kh; vcol = 384 + 64 * kh; ocol = 64 * hq;
            m_i = p.in[I_ASINK][l * 4 + hq] * LOG2E; l_i = h == 0 ? 1.0f : 0.0f; }
        else { const int uu = uidx - 32; b = uu >> 2; hd = uu & 3; qcol = 1280 + 64 * hd; kcol = 1536 + 64 * hd; vcol = 1792 + 64 * hd; ocol = 768 + 64 * hd; }
        qrow = MLAT + b * CTXL + 32 * wave + ql;
    }
    const int ctx_row0 = MLAT + b * CTXL;
    float* rpbL = (float*)(lds + A_RPB);
    float* tab = (float*)(lds + A_TAB);
    if (TYPE == 1) {
        const int ro = tid >> 5, qcl = (tid >> 1) & 15, hf = tid & 1; const int qcc = 16 * cbq + qcl, csq = min(max(qcc - 8, 0), 48);
        const float* rb = p.in[I_RPB] + (size_t)(l * 4 + hd) * 465 + ro * 31 + 15 - qcc;
        float* dst = tab + (ro * 16 + qcl) * 36 + 16 * hf;
#pragma unroll
        for (int j = 0; j < 16; ++j) { const int kc = c0 + 16 * hf + j; const bool ok = (ro < 15) && ((unsigned)(kc - csq) < 16u); float v = -1e30f; if (ok) v = rb[kc] * LOG2E; dst[j] = v; }
    }
    bf16x8 qf[4];
#pragma unroll
    for (int c = 0; c < 4; ++c) qf[c] = *(const bf16x8*)(P + (size_t)qrow * NIN + qcol + 16 * c + 8 * h);
    const int skey = tid & 63, sch = tid >> 6, sk31 = skey & 31;
    const int vpos = 32 * (skey >> 5) + 16 * (sk31 >> 4) + 8 * ((sk31 >> 2) & 1) + 4 * ((sk31 >> 3) & 1) + (sk31 & 3);
    u32x4 kraw, vraw;
#define TILE_ROW(t, krow_) do { if ((t) < 4) krow_ = ctx_row0 + 64 * (t) + skey; \
        else if (TYPE == 0) krow_ = b * SEQ + (n - 1) * 128 + 64 * (t_lo + (t) - 4) + skey; \
        else krow_ = b * SEQ + (kr_lo + 2 * ((t) - 4) + (skey >> 5)) * 64 + c0 + sk31; } while (0)
#define STAGE_LOAD(t) do { int krow_; TILE_ROW(t, krow_); kraw = *(const u32x4*)(P + (size_t)krow_ * NIN + kcol + 8 * sch); vraw = *(const u32x4*)(P + (size_t)krow_ * NIN + vcol + 8 * sch); } while (0)
#define STAGE_STORE(buf) do { *(u32x4*)(lds + A_KB + (buf) * A_KB_SZ + skey * 144 + sch * 16) = kraw; \
        unsigned short* vb_ = (unsigned short*)(lds + A_VB + (buf) * A_VB_SZ) + (8 * sch) * 72 + vpos; \
        vb_[0 * 72] = (unsigned short)(vraw.x & 0xffffu); vb_[1 * 72] = (unsigned short)(vraw.x >> 16); vb_[2 * 72] = (unsigned short)(vraw.y & 0xffffu); vb_[3 * 72] = (unsigned short)(vraw.y >> 16); \
        vb_[4 * 72] = (unsigned short)(vraw.z & 0xffffu); vb_[5 * 72] = (unsigned short)(vraw.z >> 16); vb_[6 * 72] = (unsigned short)(vraw.w & 0xffffu); vb_[7 * 72] = (unsigned short)(vraw.w >> 16); } while (0)
    STAGE_LOAD(0);
    STAGE_STORE(0);
    __syncthreads();
    f32x16 O0, O1;
#pragma unroll
    for (int i = 0; i < 16; ++i) { O0[i] = 0.f; O1[i] = 0.f; }
    for (int t = 0; t < NT; ++t) {
        const int cur = t & 1; const bool more = (t + 1) < NT;
        if (more) STAGE_LOAD(t + 1);
        bool need = true;
        if (t >= 4) { if (TYPE == 0) { const int j0 = 2 * (t_lo + t - 4); need = (j0 + 1 >= wq) && (j0 <= wq + 8); } else if (TYPE == 1) { const int kr = kr_lo + 2 * (t - 4); need = (kr + 1 >= rsa) && (kr < rsb + 8); } }
        if (need) {
            f32x16 s0, s1;
#pragma unroll
            for (int i = 0; i < 16; ++i) { s0[i] = 0.f; s1[i] = 0.f; }
            const unsigned char* kb = lds + A_KB + cur * A_KB_SZ + ql * 144 + h * 16;
#pragma unroll
            for (int c = 0; c < 4; ++c) { s0 = mfma32(*(const bf16x8*)(kb + 32 * c), qf[c], s0); s1 = mfma32(*(const bf16x8*)(kb + 32 * 144 + 32 * c), qf[c], s1); }
            if (t >= 4) {
                if (TYPE == 0) { const int kp0 = (n - 1) * 128 + 64 * (t_lo + t - 4) + 4 * h - qpos; const int kq0 = (n - 1) * 128 + 64 * (t_lo + t - 4) - (n * 128 + 32 * wq);
                  if (kq0 < 31 - 128 || kq0 + 63 > 128)
#pragma unroll
                    for (int i = 0; i < 16; ++i) { const unsigned du = (unsigned)(kp0 + 128) + (unsigned)(8 * (i >> 2) + (i & 3));
                        s0[i] = (du <= 256u) ? s0[i] : -1e30f; s1[i] = (du + 32u <= 256u) ? s1[i] : -1e30f; } }
                else if (TYPE == 1) { const int kr = kr_lo + 2 * (t - 4);
                    const int ro0 = ((unsigned)(kr - rs_q) < 8u) ? (kr - qr + 7) : 15, ro1 = ((unsigned)(kr + 1 - rs_q) < 8u) ? (kr + 1 - qr + 7) : 15;
                    const float* t0 = tab + (ro0 * 16 + (ql & 15)) * 36 + 4 * h; const float* t1 = tab + (ro1 * 16 + (ql & 15)) * 36 + 4 * h;
#pragma unroll
                    for (int g = 0; g < 4; ++g) { const f32x4 a = *(const f32x4*)(t0 + 8 * g), bq = *(const f32x4*)(t1 + 8 * g);
#pragma unroll
                        for (int j = 0; j < 4; ++j) { s0[4 * g + j] += a[j]; s1[4 * g + j] += bq[j]; } } }
            }
            const float PINF = __builtin_inff();
            float mxa = __builtin_amdgcn_fmed3f(s0[0], s0[1], PINF), mxb = __builtin_amdgcn_fmed3f(s0[8], s0[9], PINF), mxc = __builtin_amdgcn_fmed3f(s1[0], s1[1], PINF), mxd = __builtin_amdgcn_fmed3f(s1[8], s1[9], PINF);
#pragma unroll
            for (int i = 2; i < 8; ++i) { mxa = __builtin_amdgcn_fmed3f(mxa, s0[i], PINF); mxb = __builtin_amdgcn_fmed3f(mxb, s0[8 + i], PINF); mxc = __builtin_amdgcn_fmed3f(mxc, s1[i], PINF); mxd = __builtin_amdgcn_fmed3f(mxd, s1[8 + i], PINF); }
            float mx = __builtin_amdgcn_fmed3f(__builtin_amdgcn_fmed3f(mxa, mxb, PINF), __builtin_amdgcn_fmed3f(mxc, mxd, PINF), PINF);
            mx = fmaxf(mx, __shfl_xor(mx, 32));
            const float mn = fmaxf(m_i, mx); const float alpha = __builtin_amdgcn_exp2f(m_i - mn); m_i = mn;
            float la = 0.f, lb = 0.f, lc = 0.f, ld = 0.f;
#pragma unroll
            for (int i = 0; i < 16; i += 2) { s0[i] = __builtin_amdgcn_exp2f(s0[i] - mn); s0[i + 1] = __builtin_amdgcn_exp2f(s0[i + 1] - mn); s1[i] = __builtin_amdgcn_exp2f(s1[i] - mn); s1[i + 1] = __builtin_amdgcn_exp2f(s1[i + 1] - mn);
                la += s0[i]; lb += s0[i + 1]; lc += s1[i]; ld += s1[i + 1]; }
            l_i = l_i * alpha + ((la + lb) + (lc + ld));
            if (__builtin_amdgcn_ballot_w64(alpha != 1.0f) != 0ull) {
#pragma unroll
                for (int i = 0; i < 16; ++i) { O0[i] *= alpha; O1[i] *= alpha; } }
            u32x4 pw0, pw1, pw2, pw3;
            pw0.x = pk2(s0[0], s0[1]); pw0.y = pk2(s0[2], s0[3]); pw0.z = pk2(s0[4], s0[5]); pw0.w = pk2(s0[6], s0[7]);
            pw1.x = pk2(s0[8], s0[9]); pw1.y = pk2(s0[10], s0[11]); pw1.z = pk2(s0[12], s0[13]); pw1.w = pk2(s0[14], s0[15]);
            pw2.x = pk2(s1[0], s1[1]); pw2.y = pk2(s1[2], s1[3]); pw2.z = pk2(s1[4], s1[5]); pw2.w = pk2(s1[6], s1[7]);
            pw3.x = pk2(s1[8], s1[9]); pw3.y = pk2(s1[10], s1[11]); pw3.z = pk2(s1[12], s1[13]); pw3.w = pk2(s1[14], s1[15]);
            const bf16x8 pf0 = as_bf16x8(pw0), pf1 = as_bf16x8(pw1), pf2 = as_bf16x8(pw2), pf3 = as_bf16x8(pw3);
            const unsigned char* vb = lds + A_VB + cur * A_VB_SZ + ql * 144 + h * 16;
            O0 = mfma32(*(const bf16x8*)(vb), pf0, O0); O0 = mfma32(*(const bf16x8*)(vb + 32), pf1, O0); O0 = mfma32(*(const bf16x8*)(vb + 64), pf2, O0); O0 = mfma32(*(const bf16x8*)(vb + 96), pf3, O0);
            O1 = mfma32(*(const bf16x8*)(vb + 32 * 144), pf0, O1); O1 = mfma32(*(const bf16x8*)(vb + 32 * 144 + 32), pf1, O1); O1 = mfma32(*(const bf16x8*)(vb + 32 * 144 + 64), pf2, O1); O1 = mfma32(*(const bf16x8*)(vb + 32 * 144 + 96), pf3, O1);
        }
        if (more) STAGE_STORE(cur ^ 1);
        __syncthreads();
    }
#undef TILE_ROW
#undef STAGE_LOAD
#undef STAGE_STORE
    const float lt = l_i + __shfl_xor(l_i, 32); const float inv = 1.0f / lt;
    bf16* orow = MIX + (size_t)qrow * DM + ocol + 4 * h;
#pragma unroll
    for (int g4 = 0; g4 < 4; ++g4) {
        u32x2 w0, w1; w0.x = pk2(O0[4 * g4] * inv, O0[4 * g4 + 1] * inv); w0.y = pk2(O0[4 * g4 + 2] * inv, O0[4 * g4 + 3] * inv);
        w1.x = pk2(O1[4 * g4] * inv, O1[4 * g4 + 1] * inv); w1.y = pk2(O1[4 * g4 + 2] * inv, O1[4 * g4 + 3] * inv);
        *(u32x2*)(orow + 8 * g4) = w0; *(u32x2*)(orow + 32 + 8 * g4) = w1; }
}

__device__ __forceinline__ void sgu_unit(const KP& p, unsigned char* lds, int l, int R0) {
    int tid_ = threadIdx.x; asm volatile("" : "+v"(tid_));
    const int tid = tid_, lane = tid & 63, wave = __builtin_amdgcn_readfirstlane(tid >> 6), ql = lane & 31, h = lane >> 5;
    const bf16* P = (const bf16*)(p.ws + WS_P); bf16* MIX = (bf16*)(p.ws + WS_MIX);
    constexpr int VP = 136;
    unsigned short* Vt = (unsigned short*)lds;
    {
        const int token = tid >> 2, qtr = tid & 3;
        const u32x4* src = (const u32x4*)(P + (size_t)(R0 + token) * NIN + 768 + 64 * qtr);
        float v[64]; float s = 0.f;
#pragma unroll
        for (int j = 0; j < 8; ++j) { const u32x4 r = src[j];
            v[8 * j + 0] = gelu_tanh(bflo(r.x)); v[8 * j + 1] = gelu_tanh(bfhi(r.x)); v[8 * j + 2] = gelu_tanh(bflo(r.y)); v[8 * j + 3] = gelu_tanh(bfhi(r.y));
            v[8 * j + 4] = gelu_tanh(bflo(r.z)); v[8 * j + 5] = gelu_tanh(bfhi(r.z)); v[8 * j + 6] = gelu_tanh(bflo(r.w)); v[8 * j + 7] = gelu_tanh(bfhi(r.w)); }
#pragma unroll
        for (int i = 0; i < 64; ++i) s += v[i];
        s += __shfl_xor(s, 1); s += __shfl_xor(s, 2);
        const float mu = s * (1.0f / 256.0f); float q = 0.f;
#pragma unroll
        for (int i = 0; i < 64; ++i) { v[i] -= mu; q += v[i] * v[i]; }
        q += __shfl_xor(q, 1); q += __shfl_xor(q, 2);
        const float rstd = 1.0f / sqrtf(q * (1.0f / 256.0f) + EPS);
        const float* gn = p.in[I_BVG] + l * 256 + 64 * qtr;
#pragma unroll
        for (int i = 0; i < 64; ++i) Vt[(64 * qtr + i) * VP + token] = (unsigned short)f2bf(v[i] * rstd * gn[i]);
    }
    __syncthreads();
    const int g = wave >> 1, ph = wave & 1;
    f32x16 acc[2][2];
#pragma unroll
    for (int a = 0; a < 2; ++a)
#pragma unroll
        for (int c = 0; c < 2; ++c)
#pragma unroll
            for (int i = 0; i < 16; ++i) acc[a][c][i] = 0.f;
    const bf16* Wg = (const bf16*)(p.ws + WS_WSBF) + (size_t)(l * 4 + g) * 128 * 128;
#pragma unroll 2
    for (int s = 0; s < 8; ++s) {
        bf16x8 a[2], bq[2];
#pragma unroll
        for (int mb = 0; mb < 2; ++mb) a[mb] = *(const bf16x8*)(Vt + (64 * g + 32 * mb + ql) * VP + 16 * s + 8 * h);
#pragma unroll
        for (int nb = 0; nb < 2; ++nb) bq[nb] = *(const bf16x8*)(Wg + (64 * ph + 32 * nb + ql) * 128 + 16 * s + 8 * h);
#pragma unroll
        for (int mb = 0; mb < 2; ++mb)
#pragma unroll
            for (int nb = 0; nb < 2; ++nb) acc[mb][nb] = mfma32(a[mb], bq[nb], acc[mb][nb]);
    }
    u32x2 upre[2][2][4]; float bpre[2];
#pragma unroll
    for (int nb = 0; nb < 2; ++nb) { const int pp = 64 * ph + 32 * nb + ql; const size_t row = (size_t)(R0 + pp); bpre[nb] = p.in[I_BBS][(l * 4 + g) * 128 + pp];
#pragma unroll
        for (int mb = 0; mb < 2; ++mb)
#pragma unroll
            for (int g4 = 0; g4 < 4; ++g4) upre[nb][mb][g4] = *(const u32x2*)(P + row * NIN + 512 + 64 * g + 32 * mb + 8 * g4 + 4 * h); }
#pragma unroll
    for (int nb = 0; nb < 2; ++nb) { const int pp = 64 * ph + 32 * nb + ql; const size_t row = (size_t)(R0 + pp); const float bias = bpre[nb];
#pragma unroll
        for (int mb = 0; mb < 2; ++mb)
#pragma unroll
            for (int g4 = 0; g4 < 4; ++g4) { const int c = 64 * g + 32 * mb + 8 * g4 + 4 * h;
                const u32x2 ur = upre[nb][mb][g4];
                const float o0 = gelu_tanh(bflo(ur.x)) * (acc[mb][nb][4 * g4 + 0] + bias), o1 = gelu_tanh(bfhi(ur.x)) * (acc[mb][nb][4 * g4 + 1] + bias);
                const float o2 = gelu_tanh(bflo(ur.y)) * (acc[mb][nb][4 * g4 + 2] + bias), o3 = gelu_tanh(bfhi(ur.y)) * (acc[mb][nb][4 * g4 + 3] + bias);
                u32x2 w; w.x = pk2(o0, o1); w.y = pk2(o2, o3);
                *(u32x2*)(MIX + row * DM + 256 + c) = w; } }
    __syncthreads();
}

__device__ __forceinline__ void pool_unit(const KP& p, unsigned char* lds, int l, int segrow, int nseg, int t0) {
    int tid_ = threadIdx.x; asm volatile("" : "+v"(tid_));
    const int tid = tid_, lane = tid & 63, wave = __builtin_amdgcn_readfirstlane(tid >> 6), ql = lane & 31, h = lane >> 5;
    const bf16* P = (const bf16*)(p.ws + WS_P); bf16* MIX = (bf16*)(p.ws + WS_MIX);
    constexpr int RP = 528;
    for (int i = tid; i < 144 * 32; i += NTHREADS) { const int r = i >> 5, ch = i & 31, t = t0 - 8 + r; u32x4 val = (u32x4){0u, 0u, 0u, 0u};
        if (t >= 0 && t < nseg) val = *(const u32x4*)(P + (size_t)(segrow + t) * NIN + 1024 + 8 * ch);
        *(u32x4*)(lds + r * RP + ch * 16) = val; }
    __syncthreads();
    const int tb = wave & 3, gp = wave >> 2, tl = 32 * tb + ql, t = t0 + tl;
    const size_t row = (size_t)(segrow + t);
    for (int gs = 0; gs < 2; ++gs) {
        const int gi = 2 * gp + gs, half = 1 << gi;
        const int lo = max(t - half, 0), hi = min(t + half, nseg); const float inv = 1.0f / (float)(hi - lo);
        f32x16 acc[2];
#pragma unroll
        for (int a = 0; a < 2; ++a)
#pragma unroll
            for (int i = 0; i < 16; ++i) acc[a][i] = 0.f;
        const bf16* Wp = (const bf16*)(p.ws + WS_WPT) + (size_t)(l * 4 + gi) * 64 * 64;
        for (int s = 0; s < 4; ++s) {
            const unsigned char* base = lds + (tl + 8) * RP + (64 * gi + 16 * s + 8 * h) * 2;
            float sm[8];
#pragma unroll
            for (int i = 0; i < 8; ++i) sm[i] = 0.f;
            for (int r = -half; r < half; ++r) { const u32x4 v = *(const u32x4*)(base + r * RP);
                sm[0] += bflo(v.x); sm[1] += bfhi(v.x); sm[2] += bflo(v.y); sm[3] += bfhi(v.y); sm[4] += bflo(v.z); sm[5] += bfhi(v.z); sm[6] += bflo(v.w); sm[7] += bfhi(v.w); }
            const u32x4 sv = *(const u32x4*)(base);
            u32x4 w; w.x = pk2(sm[0] * inv - bflo(sv.x), sm[1] * inv - bfhi(sv.x)); w.y = pk2(sm[2] * inv - bflo(sv.y), sm[3] * inv - bfhi(sv.y));
            w.z = pk2(sm[4] * inv - bflo(sv.z), sm[5] * inv - bfhi(sv.z)); w.w = pk2(sm[6] * inv - bflo(sv.w), sm[7] * inv - bfhi(sv.w));
            const bf16x8 bfr = as_bf16x8(w);
#pragma unroll
            for (int mb = 0; mb < 2; ++mb) { const bf16x8 a = *(const bf16x8*)(Wp + (32 * mb + ql) * 64 + 16 * s + 8 * h); acc[mb] = mfma32(a, bfr, acc[mb]); }
        }
        f32x4 scp[2][4];
#pragma unroll
        for (int mb = 0; mb < 2; ++mb)
#pragma unroll
            for (int g4 = 0; g4 < 4; ++g4) scp[mb][g4] = *(const f32x4*)(p.in[I_CSC] + l * 256 + 64 * gi + 32 * mb + 8 * g4 + 4 * h);
#pragma unroll
        for (int mb = 0; mb < 2; ++mb)
#pragma unroll
            for (int g4 = 0; g4 < 4; ++g4) { const int d = 32 * mb + 8 * g4 + 4 * h; const f32x4 sc = scp[mb][g4];
                u32x2 w; w.x = pk2(acc[mb][4 * g4] * sc.x, acc[mb][4 * g4 + 1] * sc.y); w.y = pk2(acc[mb][4 * g4 + 2] * sc.z, acc[mb][4 * g4 + 3] * sc.w);
                *(u32x2*)(MIX + row * DM + 512 + 64 * gi + d) = w; }
    }
    __syncthreads();
}

__device__ __forceinline__ void phase_mixer(const KP& p, unsigned char* lds, int l, const XcdBarrier& bar) {
    for (int u = blockIdx.x; u < 768; u += gridDim.x) {
        if (u < 256) attn_unit<1>(p, lds, l, u);
        else if (u < 512) attn_unit<0>(p, lds, l, u - 256);
        else if (u < 640) sgu_unit(p, lds, l, (u - 512) * 128);
        else { const int ch = u - 640; pool_unit(p, lds, l, (ch >> 4) * SEQ, SEQ, (ch & 15) * 128); }
    }
    if (l == 0) {
        const int G = (int)gridDim.x, first = G > 96 ? G - 96 : 0;
        for (int cu = (int)blockIdx.x - first; cu < 96; cu += G) { if (cu < 0) continue;
            if (cu < 64) attn_unit<2>(p, lds, l, cu);
            else if (cu < 80) sgu_unit(p, lds, l, MLAT + (cu - 64) * 128);
            else { const int ch = cu - 80; pool_unit(p, lds, l, MLAT + (ch >> 1) * CTXL, CTXL, (ch & 1) * 128); } }
    }
}

template <int L>
__device__ __forceinline__ void ph_g1(unsigned char* lds, const float* ss) {
    const KP p = make_kp(); unsigned char* ws = p.ws;
    pg8::Gemm g{(const pg8::bf16_t*)(ws + WS_H), (const pg8::bf16_t*)(ws + WS_WIN) + (size_t)L * NIN * DM, MALL, NIN, DM, DM}; pg8::StaticOrder S; S.init(MALL, NIN, gridDim.x, blockIdx.x);
    {   const f32x4* rsrc = (const f32x4*)(ws + WS_ROPE); LAS f32x4* rdst = (LAS f32x4*)((LAS unsigned char*)lds + LDS_ROPE);
        rdst[threadIdx.x] = rsrc[threadIdx.x]; __syncthreads(); }
    EpiG1 E{(bf16*)(ws + WS_P), ss, (const float*)(ws + WS_BIAS1) + (size_t)L * 9 * NIN, p.in[I_AQG] + L * 64, p.in[I_AKG] + L * 64, p.in[I_DQG] + L * 64, p.in[I_DKG] + L * 64, (const LAS float*)((LAS unsigned char*)lds + LDS_ROPE)};
    pg8::gemm_phase<EpiG1, pg8::StaticOrder, true, true>((PG8_LAS unsigned char*)lds, g, S, E);
    if (L == 0) {
        const KP p2 = make_kp(); const int G = (int)gridDim.x, nwg = (MALL / 256) * (NIN / 256), rem = nwg % G;
        __syncthreads();
        phase_transposes(p2, lds, 1, rem, G - rem);
        __syncthreads();
        phase_bias2_f32(p2, lds, rem, G - rem);
    }
}
template <int L>
__device__ __forceinline__ void ph_g2(unsigned char* lds, float* ss) {
    const KP p = make_kp(); unsigned char* ws = p.ws;
    {   pg8::Gemm g{(const pg8::bf16_t*)(ws + WS_MIX), (const pg8::bf16_t*)(ws + WS_WOUT) + (size_t)L * DM * DM, MLAT, DM, DM, DM}; pg8::StaticOrder S; S.init(MLAT, DM, gridDim.x, blockIdx.x);
        EpiResGate<true> E{L == 0 ? p.in[I_X] : p.out, p.out, (const float*)(ws + WS_MOD) + (size_t)L * 9 * 6144 + 2048, (bf16*)(ws + WS_H), ss, (const float*)(ws + WS_GS) + (size_t)(L * 2 + 1) * 9 * 1024};
        pg8::gemm_phase<EpiResGate<true>, pg8::StaticOrder, true, true>((PG8_LAS unsigned char*)lds, g, S, E); }
    if (L == 0) {
        pg8::Gemm g{(const pg8::bf16_t*)(ws + WS_MIX) + (size_t)MLAT * DM, (const pg8::bf16_t*)(ws + WS_WOUT) + (size_t)L * DM * DM, MCTX, DM, 128, DM}; SplitKOrder S; S.init(MCTX / 256, DM / 256, 8, gridDim.x, blockIdx.x, 0);
        EpiPartial E{(float*)(ws + WS_PART2), 0};
        pg8::gemm_phase<EpiPartial, SplitKOrder, true, true>((PG8_LAS unsigned char*)lds, g, S, E); }
}
template <int L>
__device__ __forceinline__ void ph_g3(unsigned char* lds, const float* ss) {
    const KP p = make_kp(); unsigned char* ws = p.ws;
    constexpr int M = (L == 0) ? MALL : MLAT;
    pg8::Gemm g{(const pg8::bf16_t*)(ws + WS_H), (const pg8::bf16_t*)(ws + WS_WGU) + (size_t)L * NGU * DM, M, NGU, DM, DM}; pg8::StaticOrder S; S.init(M, NGU, gridDim.x, blockIdx.x);
    EpiSwiglu E{(bf16*)(ws + WS_HID), ss, (const float*)(ws + WS_BIAS2) + (size_t)L * 9 * NGU};
    pg8::gemm_phase<EpiSwiglu, pg8::StaticOrder, true, true>((PG8_LAS unsigned char*)lds, g, S, E);
}
template <int L>
__device__ __forceinline__ void ph_g4(unsigned char* lds, float* ss) {
    const KP p = make_kp(); unsigned char* ws = p.ws;
    {   pg8::Gemm g{(const pg8::bf16_t*)(ws + WS_HID), (const pg8::bf16_t*)(ws + WS_WD) + (size_t)L * DM * FF, MLAT, DM, FF, FF}; pg8::StaticOrder S; S.init(MLAT, DM, gridDim.x, blockIdx.x);
        EpiResGate<L == 0> E{p.out, p.out, (const float*)(ws + WS_MOD) + (size_t)L * 9 * 6144 + 5120, (bf16*)(ws + WS_H), ss, (const float*)(ws + WS_GS) + (size_t)(1 * 2 + 0) * 9 * 1024};
        pg8::gemm_phase<EpiResGate<L == 0>, pg8::StaticOrder, true, true>((PG8_LAS unsigned char*)lds, g, S, E); }
    if (L == 0) {
        {   pg8::Gemm g{(const pg8::bf16_t*)(ws + WS_HID) + (size_t)MLAT * FF, (const pg8::bf16_t*)(ws + WS_WD) + (size_t)L * DM * FF, MCTX, DM, 384, FF}; SplitKOrder S; S.init(MCTX / 256, DM / 256, 6, gridDim.x, blockIdx.x, 0);
            EpiPartial E{(float*)(ws + WS_PART4), 0};
            pg8::gemm_phase<EpiPartial, SplitKOrder, true, true>((PG8_LAS unsigned char*)lds, g, S, E); }
        {   pg8::Gemm g{(const pg8::bf16_t*)(ws + WS_HID) + (size_t)MLAT * FF + 2304, (const pg8::bf16_t*)(ws + WS_WD) + (size_t)L * DM * FF + 2304, MCTX, DM, 256, FF}; SplitKOrder S; S.init(MCTX / 256, DM / 256, 2, gridDim.x, blockIdx.x, 192);
            EpiPartial E{(float*)(ws + WS_PART4), 6};
            pg8::gemm_phase<EpiPartial, SplitKOrder, true, true>((PG8_LAS unsigned char*)lds, g, S, E); } }
}
#define PH_IN(k) (lo <= (k) && (k) < hi)
#define PH_SYNC(k) do { if (lo <= (k) && (k) + 1 < hi) xcd_barrier(bar); } while (0)
__global__ void __launch_bounds__(NTHREADS, 2) fwd_kernel(Params p) {
    extern __shared__ __attribute__((aligned(16))) unsigned char lds[];
    cg::grid_group grid = cg::this_grid();
    const int lo = p.ph_lo, hi = p.ph_hi;
    volatile LAS unsigned* bst = (volatile LAS unsigned*)((LAS unsigned char*)lds + 131072 + 64);
    if (threadIdx.x < 2) bst[threadIdx.x] = 0u;
    unsigned* barw = (unsigned*)(p.ws + WS_BAR);
    if (PH_IN(0)) {
        const KP kp = make_kp(); phase_prologue(kp, lds);
    }
    if (hi > 1000) grid.sync();
    XcdBarrier bar = xcd_barrier_post(barw, bst);
    __syncthreads();
    PH_SYNC(0);
    float* SS = (float*)(p.ws + WS_SS);
    if (PH_IN(1)) { const KP kp = make_kp(); phase_norm(kp, 0, 0, kp.in[I_X], kp.in[I_CTX], 0, MALL, SS); phase_tables(kp, lds, 0); }
    PH_SYNC(1);
    if (PH_IN(2)) ph_g1<0>(lds, SS);
    PH_SYNC(2);
    if (PH_IN(3)) { const KP kp = make_kp(); phase_mixer(kp, lds, 0, bar); }
    PH_SYNC(3);
    if (PH_IN(4)) ph_g2<0>(lds, SS + MALL);
    PH_SYNC(4);
    if (PH_IN(5)) { const KP kp = make_kp(); phase_norm_ctx(kp, 0, 1, 0, 2048, (const float*)(kp.ws + WS_PART2), SS + MALL); }
    PH_SYNC(5);
    if (PH_IN(6)) ph_g3<0>(lds, SS + MALL);
    PH_SYNC(6);
    if (PH_IN(7)) ph_g4<0>(lds, SS + 2 * MALL);
    PH_SYNC(7);
    if (PH_IN(8)) { const KP kp = make_kp(); phase_norm_ctx(kp, 1, 0, 0, 5120, (const float*)(kp.ws + WS_PART4), SS + 2 * MALL); }
    PH_SYNC(8);
    if (PH_IN(9)) ph_g1<1>(lds, SS + 2 * MALL);
    PH_SYNC(9);
    if (PH_IN(10)) { const KP kp = make_kp(); phase_mixer(kp, lds, 1, bar); }
    PH_SYNC(10);
    if (PH_IN(11)) ph_g2<1>(lds, SS + 3 * MALL);
    PH_SYNC(11);
    if (PH_IN(12)) ph_g3<1>(lds, SS + 3 * MALL);
    PH_SYNC(12);
    if (PH_IN(13)) ph_g4<1>(lds, nullptr);
}
}

#ifndef MK_MULTI
#define MK_MULTI 0
#endif
extern "C" void kernel_launch(void* const* d_in, const int* in_sizes, int n_in, void* d_out, int out_size, void* d_ws, size_t ws_size, hipStream_t stream) {
    using namespace mk;
    static int grid = 0;
    if (grid == 0) {
        if (n_in != 24 || out_size != MLAT * DM || ws_size < WS_END) { fprintf(stderr, "kernel_launch: unexpected problem (n_in %d out %d ws %zu need %zu)\n", n_in, out_size, ws_size, (size_t)WS_END); grid = -1; return; }
        int dev = 0, cus = 0, per_cu = 0;
        hipGetDevice(&dev); hipDeviceGetAttribute(&cus, hipDeviceAttributeMultiprocessorCount, dev);
        if (hipFuncSetAttribute((const void*)fwd_kernel, hipFuncAttributeMaxDynamicSharedMemorySize, LDS_BYTES) != hipSuccess) { fprintf(stderr, "kernel_launch: hipFuncSetAttribute failed\n"); grid = -1; return; }
        if (hipOccupancyMaxActiveBlocksPerMultiprocessor(&per_cu, (const void*)fwd_kernel, NTHREADS, LDS_BYTES) != hipSuccess || per_cu < 1) { fprintf(stderr, "kernel_launch: occupancy query gives %d\n", per_cu); per_cu = 1; }
        (void)hipGetLastError();
        grid = cus * per_cu;
        fprintf(stderr, "kernel_launch: grid %d (cus %d x %d)\n", grid, cus, per_cu);
    }
    if (grid < 0) return;
    if (hipMemsetAsync((char*)d_ws + WS_BAR, 0, 16384, stream) != hipSuccess) { fprintf(stderr, "kernel_launch: memset failed\n"); return; }
    Params p{};
    for (int i = 0; i < 24; ++i) p.in[i] = (const float*)d_in[i];
    p.out = (float*)d_out; p.ws = (unsigned char*)d_ws;
#if MK_MULTI
    for (int ph = 0; ph < 15; ++ph) { p.ph_lo = ph; p.ph_hi = ph + 1; hipLaunchKernelGGL(fwd_kernel, dim3(grid), dim3(NTHREADS), LDS_BYTES, stream, p); }
#else
    p.ph_lo = 0; p.ph_hi = 14;
    void* args[] = {&p};
    hipError_t e = hipLaunchCooperativeKernel((const void*)fwd_kernel, dim3(grid), dim3(NTHREADS), args, LDS_BYTES, stream);
    if (e != hipSuccess) fprintf(stderr, "cooperative launch failed: %s (grid %d)\n", hipGetErrorString(e), grid);
#endif
}
```

```cpp
#include <hip/hip_runtime.h>
#include <hip/hip_cooperative_groups.h>
#include <cstdio>
#include <cstdint>
namespace cg = cooperative_groups;
namespace pg8 {
#define PG8_LAS __attribute__((address_space(3)))
typedef unsigned short bf16_t;
typedef short bf16x8 __attribute__((ext_vector_type(8)));
typedef float f32x4 __attribute__((ext_vector_type(4)));
typedef unsigned u32x4 __attribute__((ext_vector_type(4)));
constexpr int BM = 256, BK = 64, HALF = 128, HTB = HALF * BK * 2  , STAGE_BYTES = 8 * HTB, NXCD = 8, WGM = 8;

__host__ __device__ __forceinline__ int lds_byte(int r, int c) { const int st = (r >> 4) * 2 + (c >> 5), rr = r & 15, cc = c & 31, ob = rr * 64 + cc * 2; return st * 1024 + (ob ^ (((ob >> 9) & 1) << 5)); }
__host__ __device__ __forceinline__ void stage_rc(int b, int& R, int& C) { const int st = b / 1024, sb = b % 1024, swz = sb ^ (((sb >> 9) & 1) << 5); R = (st >> 1) * 16 + swz / 64; C = (st & 1) * 32 + (swz % 64) / 2; }
__host__ __device__ __forceinline__ int perm32(int rho) { const int n = rho >> 4, i = rho & 15; return 8 * (i >> 2) + 4 * n + (i & 3); }

struct Unit { int pm, pn, pk; };
struct Gemm { const bf16_t* A; const bf16_t* Bt; int M, N, K, ld; };

struct StaticOrder {
    int nM, nN, nwg, G, c;
    __host__ __device__ void init(int M, int N, int G_, int c_) { nM = M / BM; nN = N / BM; nwg = nM * nN; G = G_; c = c_; }
    __host__ __device__ bool next(int i, Unit& u) const {
        const long L = (long)i * G + c; if (L >= nwg) return false;
        int wgid = (int)L; { const int q = nwg / NXCD, r = nwg % NXCD, xcd = wgid % NXCD, off = wgid / NXCD; wgid = (xcd < r ? xcd * (q + 1) : r * (q + 1) + (xcd - r) * q) + off; }
        const int wgm = (nM % 9 == 0) ? 9 : WGM;
        const int nig = wgm * nN, gid = wgid / nig, fm = gid * wgm, gsz = (nM - fm) < wgm ? (nM - fm) : wgm;
        u.pm = fm + ((wgid % nig) % gsz); u.pn = (wgid % nig) / gsz; u.pk = 0; return true;
    }
    __device__ __forceinline__ void a_ready(const Unit&) const {}
    __device__ __forceinline__ void done(const Unit&) const {}
};

__device__ __forceinline__ unsigned cvt_pk_bf16(float lo, float hi) { unsigned r; asm volatile("v_cvt_pk_bf16_f32 %0, %1, %2" : "=v"(r) : "v"(lo), "v"(hi)); return r; }
typedef float f32x2 __attribute__((ext_vector_type(2)));
__device__ __forceinline__ f32x2 gelu_pk(f32x2 v) {
    const f32x2 av = __builtin_elementwise_abs(v), d = av * 0.2316418882f + 1.0f;
    f32x2 t; t.x = __builtin_amdgcn_rcpf(d.x); t.y = __builtin_amdgcn_rcpf(d.y);
    f32x2 q = t * 0.5307027145f + (-0.7265760135f); q = q * t + 0.7107068705f; q = q * t + (-0.142248368f); q = q * t + 0.127414796f; q = q * t;
    const f32x2 s = (v * v) * (-0.72134752044f);
    f32x2 e; e.x = __builtin_amdgcn_exp2f(s.x); e.y = __builtin_amdgcn_exp2f(s.y);
    const f32x2 m = v * (q * e), r = v - m;
    f32x2 o; o.x = v.x < 0.f ? m.x : r.x; o.y = v.y < 0.f ? m.y : r.y; return o;
}

template <int ACT  > struct EpiBf16 {
    static constexpr bool PERM = true, AFTER_DRAIN = false; static_assert(ACT == 0 || ACT == 1, "EpiBf16: ACT is 0 (none) or 1 (gelu_pk)");
    bf16_t* O; int ldc; const float* bias; int split_cols; size_t split_stride; float scale0;
    __device__ __forceinline__ void operator()(const f32x4 (&acc)[2][2][4][2], const Unit& u, int wr, int wc, int fr, int fq) const {
        const int row0 = u.pm * BM + wr * 64 + fr; int colt = u.pn * BM; bf16_t* base = O;
        float sc = 1.f; if (split_cols) { const int t = colt / split_cols; base += (size_t)t * split_stride; colt -= t * split_cols; if (t == 0) sc = scale0; }
        const int col0 = colt + wc * 32 + 8 * fq, bcol0 = u.pn * BM + wc * 32 + 8 * fq;
        f32x4 bv[2][2];
#pragma unroll
        for (int bj = 0; bj < 2; ++bj)
#pragma unroll
            for (int n = 0; n < 2; ++n) bv[bj][n] = bias ? *(const f32x4*)(bias + bcol0 + bj * HALF + 4 * n) : (f32x4){0.f, 0.f, 0.f, 0.f};
#pragma unroll
        for (int ai = 0; ai < 2; ++ai)
#pragma unroll
            for (int m = 0; m < 4; ++m) { bf16_t* rowp = base + (size_t)(row0 + ai * HALF + m * 16) * ldc + col0;
#pragma unroll
                for (int bj = 0; bj < 2; ++bj) { f32x4 v0 = acc[ai][bj][m][0] + bv[bj][0], v1 = acc[ai][bj][m][1] + bv[bj][1];
                    if (ACT == 1) { f32x2 a = gelu_pk((f32x2){v0[0], v0[1]}), b = gelu_pk((f32x2){v0[2], v0[3]}), c = gelu_pk((f32x2){v1[0], v1[1]}), d = gelu_pk((f32x2){v1[2], v1[3]});
                        v0 = (f32x4){a.x, a.y, b.x, b.y}; v1 = (f32x4){c.x, c.y, d.x, d.y}; }
                    v0 = v0 * sc; v1 = v1 * sc; u32x4 w; w.x = cvt_pk_bf16(v0[0], v0[1]); w.y = cvt_pk_bf16(v0[2], v0[3]); w.z = cvt_pk_bf16(v1[0], v1[1]); w.w = cvt_pk_bf16(v1[2], v1[3]);
                    *(u32x4*)(rowp + bj * HALF) = w; } }
    }
};
template <class Epi, class Sched, bool ALIGN_EPI = false, bool SP2 = false>
__device__ __forceinline__ void gemm_phase(PG8_LAS unsigned char* lds, const Gemm g, const Sched& S, const Epi& E) {
    const int tid = threadIdx.x, wid = __builtin_amdgcn_readfirstlane(tid >> 6), lane = tid & 63, wr = wid >> 2, wc = wid & 3, fr = lane & 15, fq = lane >> 4;
    const int K = g.K, nt = K / BK;
    unsigned voffA[2], voffB[2];
#pragma unroll
    for (int i = 0; i < 2; ++i) { int R, C; stage_rc(tid * 16 + i * 8192, R, C); const int Rb = Epi::PERM ? ((R & ~31) + perm32(R & 31)) : R;
        voffA[i] = (unsigned)(R * g.ld + C) * 2u; voffB[i] = (unsigned)(Rb * g.ld + C) * 2u; }
    const size_t kstep = (size_t)(BK * 2);
    const size_t hstep = (size_t)HALF * g.ld * 2;
    const size_t tstep = 2 * hstep;
    const unsigned ldsw = (unsigned)wid * 1024u;
    const int aoff = lds_byte(wr * 64 + fr, fq * 8), boff = lds_byte(wc * 32 + fr, fq * 8);
#define PG8_SA(b, h) (((b) * 2 + (h)) * HTB)
#define PG8_SB(b, h) ((4 + (b) * 2 + (h)) * HTB)
#define PG8_STAGE(bufoff, gbase, voff) do { _Pragma("unroll") for (int _i = 0; _i < 2; ++_i) \
        __builtin_amdgcn_global_load_lds((const unsigned*)((const char*)(gbase) + (voff)[_i]), (PG8_LAS unsigned*)(lds + (bufoff) + ldsw + _i * 8192), 16, 0, 0); } while (0)
#define PG8_LDA(dst, b, h) do { _Pragma("unroll") for (int m = 0; m < 4; ++m) _Pragma("unroll") for (int k = 0; k < 2; ++k) dst[m][k] = *(const PG8_LAS bf16x8*)(lds + PG8_SA(b, h) + aoff + m * 2048 + k * 1024); } while (0)
#define PG8_LDB(dst, b, h) do { _Pragma("unroll") for (int n = 0; n < 2; ++n) _Pragma("unroll") for (int k = 0; k < 2; ++k) dst[n][k] = *(const PG8_LAS bf16x8*)(lds + PG8_SB(b, h) + boff + n * 2048 + k * 1024); } while (0)
#define PG8_MMA(ai, bj, At, Bt) do { __builtin_amdgcn_s_setprio(1); _Pragma("unroll") for (int m = 0; m < 4; ++m) _Pragma("unroll") for (int n = 0; n < 2; ++n) _Pragma("unroll") for (int k = 0; k < 2; ++k) \
        acc[ai][bj][m][n] = __builtin_amdgcn_mfma_f32_16x16x32_bf16(Bt[n][k], At[m][k], acc[ai][bj][m][n], 0, 0, 0); __builtin_amdgcn_s_setprio(0); } while (0)
#define PG8_WAIT_V(n) asm volatile("s_waitcnt vmcnt(" #n ")" ::: "memory")
#define PG8_WAIT_L(n) asm volatile("s_waitcnt lgkmcnt(" #n ")" ::: "memory")
#define PG8_BAR __builtin_amdgcn_s_barrier()
#define PG8_SCHED __builtin_amdgcn_sched_barrier(0)
    Unit cur, nxt; int ui = 0;
    if (!S.next(0, cur)) return;
    f32x4 acc[2][2][4][2];
#pragma unroll
    for (int a = 0; a < 2; ++a)
#pragma unroll
        for (int b = 0; b < 2; ++b)
#pragma unroll
            for (int m = 0; m < 4; ++m)
#pragma unroll
                for (int n = 0; n < 2; ++n) acc[a][b][m][n] = (f32x4){0.f, 0.f, 0.f, 0.f};
    bf16x8 At[4][2], B0[2][2], B1[2][2];
    const char* cA = (const char*)g.A + (size_t)cur.pm * tstep + (size_t)cur.pk * K * 2; const char* cB = (const char*)g.Bt + (size_t)cur.pn * tstep + (size_t)cur.pk * K * 2;
    S.a_ready(cur);
    if constexpr (SP2) {
        PG8_STAGE(PG8_SB(0, 0), cB, voffB); PG8_STAGE(PG8_SB(0, 1), cB + hstep, voffB); PG8_STAGE(PG8_SA(0, 0), cA, voffA); PG8_STAGE(PG8_SA(0, 1), cA + hstep, voffA);
        if (wr == 1) PG8_BAR;
        PG8_WAIT_V(2); PG8_BAR;
        PG8_STAGE(PG8_SB(1, 0), cB + kstep, voffB); PG8_STAGE(PG8_SA(1, 0), cA + kstep, voffA); PG8_STAGE(PG8_SB(1, 1), cB + hstep + kstep, voffB);
        PG8_WAIT_V(6); PG8_BAR;
    } else {
        PG8_STAGE(PG8_SB(0, 0), cB, voffB); PG8_STAGE(PG8_SA(0, 0), cA, voffA); PG8_STAGE(PG8_SB(0, 1), cB + hstep, voffB); PG8_STAGE(PG8_SA(0, 1), cA + hstep, voffA);
        if (wr == 1) PG8_BAR;
        PG8_WAIT_V(4); PG8_BAR;
        PG8_STAGE(PG8_SB(1, 0), cB + kstep, voffB); PG8_STAGE(PG8_SA(1, 0), cA + kstep, voffA); PG8_STAGE(PG8_SB(1, 1), cB + hstep + kstep, voffB);
        PG8_WAIT_V(6); PG8_BAR;
    }
    for (;;) {
        const bool has_next = S.next(ui + 1, nxt);
        const char* nA = has_next ? (const char*)g.A + (size_t)nxt.pm * tstep + (size_t)nxt.pk * K * 2 : cA; const char* nB = has_next ? (const char*)g.Bt + (size_t)nxt.pn * tstep + (size_t)nxt.pk * K * 2 : cB;
        for (int t = 0; t < nt; t += 2) {
            const bool last = (t == nt - 2);
            const char* a1 = cA + (size_t)(t + 1) * kstep;
            const char* a2 = last ? nA : cA + (size_t)(t + 2) * kstep; const char* b2 = last ? nB : cB + (size_t)(t + 2) * kstep;
            const char* a3 = a2 + kstep; const char* b3 = b2 + kstep;
            if (last && has_next) S.a_ready(nxt);
            if constexpr (SP2) {
            PG8_LDB(B0, 0, 0); PG8_LDB(B1, 0, 1); PG8_SCHED; PG8_LDA(At, 0, 0); PG8_STAGE(PG8_SA(1, 1), a1 + hstep, voffA);
            PG8_WAIT_V(8); PG8_WAIT_L(0); PG8_BAR; PG8_MMA(0, 0, At, B0); PG8_MMA(0, 1, At, B1); PG8_BAR; PG8_SCHED;
            PG8_LDA(At, 0, 1); PG8_STAGE(PG8_SB(0, 0), b2, voffB); PG8_STAGE(PG8_SB(0, 1), b2 + hstep, voffB); PG8_STAGE(PG8_SA(0, 0), a2, voffA);
            PG8_WAIT_V(8); PG8_WAIT_L(0); PG8_BAR; PG8_MMA(1, 0, At, B0); PG8_MMA(1, 1, At, B1); PG8_BAR; PG8_SCHED;
            PG8_LDB(B0, 1, 0); PG8_LDB(B1, 1, 1); PG8_SCHED; PG8_LDA(At, 1, 0); PG8_STAGE(PG8_SA(0, 1), a2 + hstep, voffA);
            PG8_WAIT_V(8); PG8_WAIT_L(0); PG8_BAR; PG8_MMA(0, 0, At, B0); PG8_MMA(0, 1, At, B1); PG8_BAR; PG8_SCHED;
            PG8_LDA(At, 1, 1); PG8_STAGE(PG8_SB(1, 0), b3, voffB); PG8_STAGE(PG8_SB(1, 1), b3 + hstep, voffB); PG8_STAGE(PG8_SA(1, 0), a3, voffA);
            PG8_WAIT_V(8); PG8_WAIT_L(0); PG8_BAR; PG8_MMA(1, 0, At, B0); PG8_MMA(1, 1, At, B1); PG8_BAR; PG8_SCHED;
            } else {
            PG8_LDB(B0, 0, 0); PG8_SCHED; PG8_LDA(At, 0, 0); PG8_STAGE(PG8_SA(1, 1), a1 + hstep, voffA);
            PG8_WAIT_L(8); PG8_BAR; PG8_WAIT_L(0); PG8_MMA(0, 0, At, B0); PG8_BAR; PG8_SCHED;
            PG8_LDB(B1, 0, 1); PG8_STAGE(PG8_SB(0, 0), b2, voffB);
            PG8_BAR; PG8_WAIT_L(0); PG8_MMA(0, 1, At, B1); PG8_BAR;
            PG8_LDA(At, 0, 1); PG8_STAGE(PG8_SA(0, 0), a2, voffA);
            PG8_BAR; PG8_WAIT_L(0); PG8_MMA(1, 0, At, B0); PG8_BAR; PG8_SCHED;
            PG8_STAGE(PG8_SB(0, 1), b2 + hstep, voffB);
            PG8_WAIT_V(6); PG8_BAR; PG8_MMA(1, 1, At, B1); PG8_BAR;
            PG8_LDB(B0, 1, 0); PG8_SCHED; PG8_LDA(At, 1, 0); PG8_STAGE(PG8_SA(0, 1), a2 + hstep, voffA);
            PG8_WAIT_L(8); PG8_BAR; PG8_WAIT_L(0); PG8_MMA(0, 0, At, B0); PG8_BAR; PG8_SCHED;
            PG8_LDB(B1, 1, 1); PG8_STAGE(PG8_SB(1, 0), b3, voffB);
            PG8_BAR; PG8_WAIT_L(0); PG8_MMA(0, 1, At, B1); PG8_BAR;
            PG8_LDA(At, 1, 1); PG8_STAGE(PG8_SA(1, 0), a3, voffA);
            PG8_BAR; PG8_WAIT_L(0); PG8_MMA(1, 0, At, B0); PG8_BAR; PG8_SCHED;
            PG8_STAGE(PG8_SB(1, 1), b3 + hstep, voffB);
            PG8_WAIT_V(6); PG8_BAR; PG8_MMA(1, 1, At, B1); PG8_BAR;
            }
        }
        if constexpr (ALIGN_EPI) { if (wr == 0) PG8_BAR; }
        if constexpr (!Epi::AFTER_DRAIN) { E(acc, cur, wr, wc, fr, fq); S.done(cur); }
        if (!has_next) break;
#pragma unroll
        for (int a = 0; a < 2; ++a)
#pragma unroll
            for (int b = 0; b < 2; ++b)
#pragma unroll
                for (int m = 0; m < 4; ++m)
#pragma unroll
                    for (int n = 0; n < 2; ++n) acc[a][b][m][n] = (f32x4){0.f, 0.f, 0.f, 0.f};
        cur = nxt; cA = nA; cB = nB; ++ui;
        if constexpr (ALIGN_EPI) { if (wr == 1) PG8_BAR; }
    }
    PG8_WAIT_V(0);
    if constexpr (!ALIGN_EPI) { if (wr == 0) PG8_BAR; }
    PG8_BAR;
    if constexpr (Epi::AFTER_DRAIN) { E.fused(acc, cur, wr, wc, fr, fq, lds, wid, lane); S.done(cur); }
#undef PG8_SA
#undef PG8_SB
#undef PG8_STAGE
#undef PG8_LDA
#undef PG8_LDB
#undef PG8_MMA
#undef PG8_WAIT_V
#undef PG8_WAIT_L
#undef PG8_BAR
#undef PG8_SCHED
}
}

namespace mk {
#define LAS __attribute__((address_space(3)))
typedef unsigned short bf16;
typedef short bf16x8 __attribute__((ext_vector_type(8)));
typedef float f32x4 __attribute__((ext_vector_type(4)));
typedef float f32x16 __attribute__((ext_vector_type(16)));
typedef unsigned u32x4 __attribute__((ext_vector_type(4)));
typedef unsigned u32x2 __attribute__((ext_vector_type(2)));

constexpr int DM = 1024, MLAT = 16384, MCTX = 2048, MALL = 18432, NIN = 2048, FF = 2816, NGU = 5632, SEQ = 2048, CTXL = 256;
constexpr float EPS = 1e-6f, LOG2E = 1.4426950408889634f;
constexpr int NTHREADS = 512, NWAVES = 8;
constexpr int LDS_BYTES = 143360;
constexpr int LDS_ROPE = 131072 + 1024;

constexpr size_t WS_WIN = 0;
constexpr size_t WS_WOUT = WS_WIN + 2ull * NIN * DM * 2;
constexpr size_t WS_WGU = WS_WOUT + 2ull * DM * DM * 2;
constexpr size_t WS_WD = WS_WGU + 2ull * NGU * DM * 2;
constexpr size_t WS_MOD = WS_WD + 2ull * DM * FF * 2;
constexpr size_t WS_ROPE = WS_MOD + 2ull * 9 * 6144 * 4;
constexpr size_t WS_WSBF = WS_ROPE + 8192;
constexpr size_t WS_WPT = WS_WSBF + 2ull * 4 * 128 * 128 * 2;
constexpr size_t WS_XC = WS_WPT + 2ull * 4 * 64 * 64 * 2;
constexpr size_t WS_BAR = WS_XC + (size_t)MCTX * DM * 4;
constexpr size_t WS_GS = WS_BAR + 16384;
constexpr size_t WS_BIAS1 = WS_GS + 2ull * 2 * 9 * 1024 * 4;
constexpr size_t WS_BIAS2 = WS_BIAS1 + 2ull * 9 * NIN * 4;
constexpr size_t WS_SS = WS_BIAS2 + 2ull * 9 * NGU * 4;
constexpr size_t WS_H = WS_SS + 4ull * MALL * 4;
constexpr size_t WS_P = WS_H + (size_t)MALL * DM * 2;
constexpr size_t WS_MIX = WS_P + (size_t)MALL * NIN * 2;
constexpr size_t WS_HID = WS_P;
constexpr size_t WS_PART2 = WS_P;
constexpr size_t WS_PART4 = WS_HID + (size_t)MALL * FF * 2;
constexpr size_t WS_END = WS_PART4 + 8ull * MCTX * DM * 4;
static_assert((size_t)MALL * FF * 2 <= (size_t)MALL * NIN * 2 + (size_t)MALL * DM * 2, "HID overlay");

struct Params { const float* in[24]; float* out; unsigned char* ws; int ph_lo, ph_hi; };
typedef const __attribute__((address_space(4))) Params* KArgPtr;
struct KIn { KArgPtr k; __device__ __forceinline__ const float* operator[](int i) const { return k->in[i]; } };
struct KP { KIn in; float* out; unsigned char* ws; };
__device__ __forceinline__ KP make_kp() { KArgPtr k = (KArgPtr)__builtin_amdgcn_kernarg_segment_ptr(); asm volatile("" : "+s"(k));
    KP p; p.in.k = k; p.out = p.in.k->out; p.ws = p.in.k->ws; return p; }
enum { I_X = 0, I_C, I_CTX, I_CCTX, I_WMOD, I_BMOD, I_GMIX, I_GFFN, I_WIN, I_WOUT, I_AQG, I_AKG, I_ASINK, I_BVG, I_BWS, I_BBS, I_CWP, I_CSC, I_DQG, I_DKG, I_RPB, I_WG, I_WU, I_WDN };

__device__ __forceinline__ unsigned f2bf(float f) { unsigned u = __float_as_uint(f); return (u + 0x7fffu + ((u >> 16) & 1u)) >> 16; }
typedef __bf16 bf16x2_t __attribute__((ext_vector_type(2)));
__device__ __forceinline__ unsigned pk2(float lo, float hi) { bf16x2_t v; v.x = (__bf16)lo; v.y = (__bf16)hi; return __builtin_bit_cast(unsigned, v); }
__device__ __forceinline__ float bflo(unsigned w) { return __uint_as_float(w << 16); }
__device__ __forceinline__ float bfhi(unsigned w) { return __uint_as_float(w & 0xffff0000u); }
__device__ __forceinline__ float wave_sum(float v) {
#pragma unroll
    for (int o = 1; o < 64; o <<= 1) v += __shfl_xor(v, o);
    return v;
}
__device__ __forceinline__ float gelu_tanh(float x) {
    const float u = 0.7978845608028654f * (x + 0.044715f * x * x * x);
    const float t = __builtin_amdgcn_exp2f(u * (2.0f * LOG2E));
    const float th = 1.0f - 2.0f * __builtin_amdgcn_rcpf(t + 1.0f);
    return 0.5f * x * (1.0f + th);
}
__device__ __forceinline__ float silu_f(float x) { return x / (1.0f + __expf(-x)); }
__device__ __forceinline__ f32x16 mfma32(bf16x8 a, bf16x8 b, f32x16 c) { return __builtin_amdgcn_mfma_f32_32x32x16_bf16(a, b, c, 0, 0, 0); }
__device__ __forceinline__ bf16x8 as_bf16x8(u32x4 v) { return __builtin_bit_cast(bf16x8, v); }

template <bool WITH_H>
struct EpiResGate {
    static constexpr bool PERM = true, AFTER_DRAIN = false;
    const float* src; float* dst; const float* gate; bf16* H; float* ss; const float* gs;
    __device__ __forceinline__ void operator()(const pg8::f32x4 (&acc)[2][2][4][2], const pg8::Unit& u, int wr, int wc, int fr, int fq) const {
        const int rbase = u.pm * 256 + wr * 64 + fr;
        const int bb = u.pm >> 3;
        const float* gr = gate + bb * 6144;
        const int col0 = u.pn * 256 + wc * 32 + 8 * fq;
        pg8::f32x4 gv[2][2], sv[2][2];
#pragma unroll
        for (int bj = 0; bj < 2; ++bj)
#pragma unroll
            for (int n = 0; n < 2; ++n) { gv[bj][n] = *(const pg8::f32x4*)(gr + col0 + bj * 128 + n * 4); if (WITH_H) sv[bj][n] = *(const pg8::f32x4*)(gs + bb * 1024 + col0 + bj * 128 + n * 4); }
        pg8::f32x4 xb[2][2][2];
        { const size_t off = (size_t)rbase * DM + col0;
#pragma unroll
          for (int bj = 0; bj < 2; ++bj)
#pragma unroll
            for (int n = 0; n < 2; ++n) xb[0][bj][n] = *(const pg8::f32x4*)(src + off + bj * 128 + n * 4); }
#pragma unroll
        for (int r = 0; r < 8; ++r) { const int ai = r >> 2, m = r & 3;
            if (r + 1 < 8) { const size_t off2 = (size_t)(rbase + ((r + 1) >> 2) * 128 + ((r + 1) & 3) * 16) * DM + col0;
#pragma unroll
                for (int bj = 0; bj < 2; ++bj)
#pragma unroll
                    for (int n = 0; n < 2; ++n) xb[(r + 1) & 1][bj][n] = *(const pg8::f32x4*)(src + off2 + bj * 128 + n * 4); }
            const int row = rbase + ai * 128 + m * 16; const size_t off = (size_t)row * DM + col0; float q = 0.f;
#pragma unroll
            for (int bj = 0; bj < 2; ++bj) { pg8::f32x4 xn[2];
#pragma unroll
                for (int n = 0; n < 2; ++n) { const pg8::f32x4 xv = xb[r & 1][bj][n];
                    xn[n] = xv + gv[bj][n] * acc[ai][bj][m][n];
                    *(pg8::f32x4*)(dst + off + bj * 128 + n * 4) = xn[n];
                    if (WITH_H) q += (xn[n][0] * xn[n][0] + xn[n][1] * xn[n][1]) + (xn[n][2] * xn[n][2] + xn[n][3] * xn[n][3]); }
                if (WITH_H) { const pg8::f32x4 h0 = xn[0] * sv[bj][0], h1 = xn[1] * sv[bj][1];
                    u32x4 w; w.x = pk2(h0[0], h0[1]); w.y = pk2(h0[2], h0[3]); w.z = pk2(h1[0], h1[1]); w.w = pk2(h1[2], h1[3]); *(u32x4*)(H + off + bj * 128) = w; } }
            if (WITH_H) { q += __shfl_xor(q, 16); q += __shfl_xor(q, 32); if (fq == 0) __hip_atomic_fetch_add(ss + row, q, __ATOMIC_RELAXED, __HIP_MEMORY_SCOPE_AGENT); } }
    }
};
struct EpiPartial {
    static constexpr bool PERM = false, AFTER_DRAIN = false;
    float* dst; int slot0;
    __device__ __forceinline__ void operator()(const pg8::f32x4 (&acc)[2][2][4][2], const pg8::Unit& u, int wr, int wc, int fr, int fq) const {
        const int rbase = u.pm * 256 + wr * 64 + fr, col0 = u.pn * 256 + wc * 32 + 4 * fq;
        float* base = dst + (size_t)(slot0 + u.pk) * MCTX * DM;
#pragma unroll
        for (int ai = 0; ai < 2; ++ai)
#pragma unroll
            for (int m = 0; m < 4; ++m) { float* d = base + (size_t)(rbase + ai * 128 + m * 16) * DM + col0;
#pragma unroll
                for (int bj = 0; bj < 2; ++bj)
#pragma unroll
                    for (int n = 0; n < 2; ++n) *(pg8::f32x4*)(d + bj * 128 + n * 16) = acc[ai][bj][m][n]; }
    }
};
struct SplitKOrder {
    int nsplit, nN, nunits, G, c;
    __device__ void init(int nM, int nN_, int nsplit_, int G_, int c_, int rot) { nsplit = nsplit_; nN = nN_; nunits = nM * nN_ * nsplit_; G = G_; c = (c_ + G_ - rot) % G_; }
    __device__ bool next(int i, pg8::Unit& u) const { const int L = i * G + c; if (L >= nunits) return false; const int tile = L / nsplit; u.pk = L - tile * nsplit; u.pm = tile / nN; u.pn = tile - u.pm * nN; return true; }
    __device__ __forceinline__ void a_ready(const pg8::Unit&) const {}
    __device__ __forceinline__ void done(const pg8::Unit&) const {}
};
__device__ __forceinline__ float row_rstd(const float* ss, int row) { return 1.0f / sqrtf(ss[row] * (1.0f / DM) + EPS); }
struct EpiG1 {
    static constexpr bool PERM = true, AFTER_DRAIN = false;
    bf16* O; const float* ss; const float* bias; const float* aqg; const float* akg; const float* dqg; const float* dkg; const LAS float* rope;
    __device__ __forceinline__ void operator()(const pg8::f32x4 (&acc)[2][2][4][2], const pg8::Unit& u, int wr, int wc, int fr, int fq) const {
        const bool lat = u.pm < (MLAT / 256);
        const int bb = lat ? (u.pm >> 3) : 8;
        const int row0 = u.pm * 256 + wr * 64 + fr;
        const float* br = bias + bb * NIN + u.pn * 256 + wc * 32 + 8 * fq;
        const int colL = u.pn * 256 + 64 * wc + 8 * fq;
        const float* gain = nullptr; float qs = 1.0f; int mode = 0;
        if (u.pn == 0) { gain = aqg; qs = 0.125f * LOG2E; mode = 2; }
        else if (u.pn == 1 && wc < 2) { gain = akg; mode = 2; }
        else if (u.pn == 5) { gain = dqg; qs = 0.125f * LOG2E; mode = 1; }
        else if (u.pn == 6) { gain = dkg; mode = 1; }
        if (mode == 2 && !lat) mode = 1;
        pg8::f32x4 bv[2][2], gn[2][2];
#pragma unroll
        for (int bj = 0; bj < 2; ++bj)
#pragma unroll
            for (int n = 0; n < 2; ++n) { bv[bj][n] = *(const pg8::f32x4*)(br + bj * 128 + 4 * n); gn[bj][n] = mode ? *(const pg8::f32x4*)(gain + 32 * bj + 8 * fq + 4 * n) : (pg8::f32x4){1.f, 1.f, 1.f, 1.f}; }
        const float sgn = fq < 2 ? -1.0f : 1.0f;
        float rsv[2][4];
#pragma unroll
        for (int ai = 0; ai < 2; ++ai)
#pragma unroll
            for (int m = 0; m < 4; ++m) rsv[ai][m] = ss[row0 + ai * 128 + m * 16];
#pragma unroll
        for (int ai = 0; ai < 2; ++ai)
#pragma unroll
            for (int m = 0; m < 4; ++m) { const int row = row0 + ai * 128 + m * 16; const float rs = __builtin_amdgcn_rsqf(rsv[ai][m] * (1.0f / DM) + EPS);
                pg8::f32x4 v[2][2];
#pragma unroll
                for (int bj = 0; bj < 2; ++bj)
#pragma unroll
                    for (int n = 0; n < 2; ++n) v[bj][n] = acc[ai][bj][m][n] * rs + bv[bj][n];
                if (mode) {
                    float q = 0.f;
#pragma unroll
                    for (int bj = 0; bj < 2; ++bj)
#pragma unroll
                        for (int n = 0; n < 2; ++n) q += (v[bj][n][0] * v[bj][n][0] + v[bj][n][1] * v[bj][n][1]) + (v[bj][n][2] * v[bj][n][2] + v[bj][n][3] * v[bj][n][3]);
                    q += __shfl_xor(q, 16); q += __shfl_xor(q, 32);
                    const float hr = __builtin_amdgcn_rsqf(q * (1.0f / 64.0f) + EPS) * qs;
#pragma unroll
                    for (int bj = 0; bj < 2; ++bj)
#pragma unroll
                        for (int n = 0; n < 2; ++n) v[bj][n] = v[bj][n] * hr * gn[bj][n];
                    if (mode == 2) {
                        const int pos = row & (SEQ - 1);
#pragma unroll
                        for (int bj = 0; bj < 2; ++bj) { const int pp = bj ? (pos & 63) : (pos >> 6);
#pragma unroll
                            for (int n = 0; n < 2; ++n) { const LAS float* tb = rope + (pp * 16 + 8 * (fq & 1) + 4 * n) * 2;
                                const pg8::f32x4 cs0 = *(const LAS pg8::f32x4*)(tb), cs1 = *(const LAS pg8::f32x4*)(tb + 4);
                                const float co[4] = {cs0[0], cs0[2], cs1[0], cs1[2]}, sn[4] = {cs0[1], cs0[3], cs1[1], cs1[3]};
#pragma unroll
                                for (int j = 0; j < 4; ++j) { const float own = v[bj][n][j]; const float oth = __shfl_xor(own, 32); v[bj][n][j] = own * co[j] + sgn * oth * sn[j]; } } }
                    }
                }
#pragma unroll
                for (int bj = 0; bj < 2; ++bj) { u32x4 w; w.x = pk2(v[bj][0][0], v[bj][0][1]); w.y = pk2(v[bj][0][2], v[bj][0][3]); w.z = pk2(v[bj][1][0], v[bj][1][1]); w.w = pk2(v[bj][1][2], v[bj][1][3]);
                    *(u32x4*)(O + (size_t)row * NIN + colL + 32 * bj) = w; } }
    }
};
struct EpiSwiglu {
    static constexpr bool PERM = true, AFTER_DRAIN = false;
    bf16* O; const float* ss; const float* bias;
    __device__ __forceinline__ void operator()(const pg8::f32x4 (&acc)[2][2][4][2], const pg8::Unit& u, int wr, int wc, int fr, int fq) const {
        const int bb = u.pm >= (MLAT / 256) ? 8 : (u.pm >> 3);
        const int row0 = u.pm * 256 + wr * 64 + fr, col0 = u.pn * 128 + wc * 32 + 8 * fq;
        const float* br = bias + bb * NGU + u.pn * 256 + wc * 32 + 8 * fq;
        pg8::f32x4 bg[2], bu[2];
#pragma unroll
        for (int n = 0; n < 2; ++n) { bg[n] = *(const pg8::f32x4*)(br + 4 * n); bu[n] = *(const pg8::f32x4*)(br + 128 + 4 * n); }
        float rsv[2][4];
#pragma unroll
        for (int ai = 0; ai < 2; ++ai)
#pragma unroll
            for (int m = 0; m < 4; ++m) rsv[ai][m] = ss[row0 + ai * 128 + m * 16];
#pragma unroll
        for (int ai = 0; ai < 2; ++ai)
#pragma unroll
            for (int m = 0; m < 4; ++m) { const int row = row0 + ai * 128 + m * 16; const float rs = __builtin_amdgcn_rsqf(rsv[ai][m] * (1.0f / DM) + EPS);
                float hv[8];
#pragma unroll
                for (int n = 0; n < 2; ++n)
#pragma unroll
                    for (int j = 0; j < 4; ++j) { const float g = acc[ai][0][m][n][j] * rs + bg[n][j], up = acc[ai][1][m][n][j] * rs + bu[n][j]; hv[4 * n + j] = g * __builtin_amdgcn_rcpf(1.0f + __builtin_amdgcn_exp2f(-g * LOG2E)) * up; }
                u32x4 w; w.x = pk2(hv[0], hv[1]); w.y = pk2(hv[2], hv[3]); w.z = pk2(hv[4], hv[5]); w.w = pk2(hv[6], hv[7]);
                *(u32x4*)(O + (size_t)row * FF + col0) = w; }
    }
};

typedef unsigned gu32;
#define XB_TMO      128
#define XB_XCNT(j)  (256  + 64 * (j))
#define XB_XSUB(j)  (1280 + 64 * (j))
#define XB_XGEN(j)  (2304 + 64 * (j))
#define XB_TOP      3328
#define XB_TOPGEN   3392
#define XCD_BAR_WORDS 3456
#define XB_SPIN_CAP (1u << 18)

__device__ __forceinline__ unsigned xb_ld(unsigned* p)              { return __hip_atomic_load(p, __ATOMIC_RELAXED, __HIP_MEMORY_SCOPE_AGENT); }
__device__ __forceinline__ unsigned xb_add(unsigned* p, unsigned v) { return __hip_atomic_fetch_add(p, v, __ATOMIC_RELAXED, __HIP_MEMORY_SCOPE_AGENT); }
__device__ __forceinline__ unsigned xb_xcc_id() { return (unsigned)__builtin_amdgcn_s_getreg((3 << 11) | 20) & 0xFu; }
#define XB_SPIN(cond, bar) do { unsigned _sp = 0; while (cond) { __builtin_amdgcn_s_sleep(1); \
    if ((++_sp & 255u) == 0u) { if (xb_ld(&(bar)[XB_TMO])) break; if (_sp > XB_SPIN_CAP) { atomicAdd(&(bar)[XB_TMO], 1u); break; } } } } while (0)

struct XcdBarrier {
    unsigned* bar; unsigned x;
    volatile LAS unsigned* st;
};

__device__ __forceinline__ XcdBarrier xcd_barrier_post(unsigned* bar, volatile LAS unsigned* st) {
    XcdBarrier b; b.bar = bar; b.x = xb_xcc_id(); b.st = st;
    if (threadIdx.x == 0) (void)xb_add(&bar[XB_XCNT(b.x)], 1u);
    return b;
}
__device__ __forceinline__ void xcd_barrier_complete(unsigned* bar, unsigned x, unsigned& nloc, unsigned& nx) {
    const unsigned G = gridDim.x * gridDim.y * gridDim.z;
    unsigned sum, cnt, mine, sp = 0u;
    for (;;) {
        sum = 0u; cnt = 0u; mine = 0u;
#pragma unroll
        for (unsigned j = 0; j < 16; ++j) { const unsigned c = xb_ld(&bar[XB_XCNT(j)]); sum += c; cnt += (c > 0u) ? 1u : 0u; mine = (j == x) ? c : mine; }
        if (sum == G) break;
        __builtin_amdgcn_s_sleep(1);
        if ((++sp & 255u) == 0u) { if (xb_ld(&bar[XB_TMO])) break; if (sp > XB_SPIN_CAP) { atomicAdd(&bar[XB_TMO], 1u); break; } }
    }
    nloc = mine > 0u ? mine : 1u; nx = cnt > 0u ? cnt : 1u;
}

__device__ __forceinline__ void xcd_barrier(const XcdBarrier& b) {
    asm volatile("s_waitcnt vmcnt(0)" ::: "memory");
    __syncthreads();
    if (threadIdx.x == 0) {
        unsigned* bar = b.bar;
        __builtin_amdgcn_s_waitcnt(0);
        unsigned nloc = b.st[0], nx = b.st[1];
        if (nloc == 0u) { xcd_barrier_complete(bar, b.x, nloc, nx); b.st[0] = nloc; b.st[1] = nx; }
        const unsigned old = xb_add(&bar[XB_XSUB(b.x)], 1u);
        const unsigned gen = old / nloc;
        if (old + 1u == (gen + 1u) * nloc) {
            __builtin_amdgcn_fence(__ATOMIC_RELEASE, "agent");
            asm volatile("s_waitcnt vmcnt(0)" ::: "memory");
            const unsigned og = xb_add(&bar[XB_TOP], 1u);
            const unsigned tg = og / nx;
            if (og + 1u == (tg + 1u) * nx) xb_add(&bar[XB_TOPGEN], 1u);
            else XB_SPIN(xb_ld(&bar[XB_TOPGEN]) == tg, bar);
            __builtin_amdgcn_fence(__ATOMIC_ACQUIRE, "agent");
            xb_add(&bar[XB_XGEN(b.x)], 1u);
            asm volatile("s_waitcnt vmcnt(0)" ::: "memory");
        } else {
            XB_SPIN(xb_ld(&bar[XB_XGEN(b.x)]) == gen, bar);
            __builtin_amdgcn_fence(__ATOMIC_ACQUIRE, "agent");
            asm volatile("s_waitcnt vmcnt(0)" ::: "memory");
        }
    }
    __syncthreads();
}
__device__ __forceinline__ void transpose_item(const float* W, int K, int N, bf16* WT, int k0, int n0, int drow, float* scr, int lane) {
    float tv[32];
#pragma unroll
    for (int i = 0; i < 32; ++i) tv[i] = W[(size_t)(k0 + 2 * i + (lane >> 5)) * N + n0 + (lane & 31)];
#pragma unroll
    for (int i = 0; i < 32; ++i) scr[(2 * i + (lane >> 5)) * 33 + (lane & 31)] = tv[i];
    asm volatile("s_waitcnt lgkmcnt(0)" ::: "memory");
    const int c = lane & 7;
#pragma unroll
    for (int j = 0; j < 4; ++j) { const int n = (lane >> 3) + 8 * j; const float* s = scr + (8 * c) * 33 + n;
        u32x4 o; o.x = pk2(s[0 * 33], s[1 * 33]); o.y = pk2(s[2 * 33], s[3 * 33]); o.z = pk2(s[4 * 33], s[5 * 33]); o.w = pk2(s[6 * 33], s[7 * 33]);
        *(u32x4*)(WT + (size_t)(drow + n) * K + k0 + 8 * c) = o; }
    asm volatile("s_waitcnt lgkmcnt(0)" ::: "memory");
}

__device__ __forceinline__ void phase_transposes(const KP& p, unsigned char* lds, int part, int first_blk, int nblk) {
    const int lane = threadIdx.x & 63, wave = threadIdx.x >> 6;
    unsigned char* ws = p.ws;
    float* scr = (float*)(lds + wave * 16384);
    if ((int)blockIdx.x < first_blk) return;
    const int gw = ((int)blockIdx.x - first_blk) * NWAVES + wave, NGW = nblk * NWAVES;
    if (part == 0) {
        for (int it = gw; it < 2 * 1024; it += NGW) { const int l = it >> 10, r = it & 1023; const int kb = r >> 6, nb = r & 63;
            transpose_item(p.in[I_WIN] + (size_t)l * DM * NIN, DM, NIN, (bf16*)(ws + WS_WIN) + (size_t)l * NIN * DM, 64 * kb, 32 * nb, 256 * (nb >> 3) + 128 * (nb & 1) + 32 * ((nb >> 1) & 3), scr, lane); }
        return;
    }
    for (int it = gw; it < 2 * 4736; it += NGW) {
        const int l = it / 4736; int r = it % 4736;
        if (r < 512) { const int kb = r >> 5, nb = r & 31; transpose_item(p.in[I_WOUT] + (size_t)l * DM * DM, DM, DM, (bf16*)(ws + WS_WOUT) + (size_t)l * DM * DM, 64 * kb, 32 * nb, 32 * nb, scr, lane); continue; } r -= 512;
        if (r < 1408) { const int kb = r / 88, nb = r % 88, n0 = 32 * nb; transpose_item(p.in[I_WG] + (size_t)l * DM * FF, DM, FF, (bf16*)(ws + WS_WGU) + (size_t)l * NGU * DM, 64 * kb, n0, 256 * (n0 >> 7) + (n0 & 127), scr, lane); continue; } r -= 1408;
        if (r < 1408) { const int kb = r / 88, nb = r % 88, n0 = 32 * nb; transpose_item(p.in[I_WU] + (size_t)l * DM * FF, DM, FF, (bf16*)(ws + WS_WGU) + (size_t)l * NGU * DM, 64 * kb, n0, 256 * (n0 >> 7) + 128 + (n0 & 127), scr, lane); continue; } r -= 1408;
        { const int kb = r >> 5, nb = r & 31; transpose_item(p.in[I_WDN] + (size_t)l * FF * DM, FF, DM, (bf16*)(ws + WS_WD) + (size_t)l * DM * FF, 64 * kb, 32 * nb, 32 * nb, scr, lane); }
    }
}
__device__ __forceinline__ void phase_prologue(const KP& p, unsigned char* lds) {
    const int tid = threadIdx.x, lane = tid & 63, wave = tid >> 6;
    unsigned char* ws = p.ws;
    if (blockIdx.x < 192) {
        const int l = blockIdx.x / 96, c0 = 64 * (blockIdx.x % 96);
        float* act = (float*)lds;
        for (int i = tid; i < 9 * 1024; i += NTHREADS) { const int bb = i >> 10, k = i & 1023; const float v = bb < 8 ? p.in[I_C][bb * 1024 + k] : p.in[I_CCTX][k]; act[i] = v / (1.0f + expf(-v)); }
        __syncthreads();
        const float* w = p.in[I_WMOD] + (size_t)l * 1024 * 6144 + c0 + lane;
        float acc[9];
#pragma unroll
        for (int b = 0; b < 9; ++b) acc[b] = 0.f;
        const int kbeg = wave * 128;
#pragma unroll 32
        for (int k = kbeg; k < kbeg + 128; ++k) { const float wv = w[(size_t)k * 6144];
#pragma unroll
            for (int b = 0; b < 9; ++b) acc[b] += act[b * 1024 + k] * wv; }
        float* red = (float*)(lds + 40960);
#pragma unroll
        for (int b = 0; b < 9; ++b) red[(wave * 9 + b) * 64 + lane] = acc[b];
        __syncthreads();
        float* mod = (float*)(ws + WS_MOD);
        for (int i = tid; i < 576; i += NTHREADS) { const int b = i >> 6, cc = i & 63; float s = p.in[I_BMOD][l * 6144 + c0 + cc];
#pragma unroll
            for (int wv = 0; wv < 8; ++wv) s += red[(wv * 9 + b) * 64 + cc];
            mod[(size_t)(l * 9 + b) * 6144 + c0 + cc] = s; }
        __syncthreads();
    } else {
        const int g = (blockIdx.x - 192) * NTHREADS + tid;
        if (g < 1024) { const int pos = g >> 4, f = g & 15; const float inv = powf(10000.0f, -(float)f / 16.0f); const float ang = (float)pos * inv;
            float* rope = (float*)(ws + WS_ROPE); rope[2 * g] = cosf(ang); rope[2 * g + 1] = sinf(ang); }
        bf16* wsbf = (bf16*)(ws + WS_WSBF);
        for (int i = g; i < 2 * 4 * 128 * 128; i += 32768) wsbf[i] = (bf16)f2bf(p.in[I_BWS][i]);
        bf16* wpt = (bf16*)(ws + WS_WPT);
        { const int i = g; const int lg = i >> 12, rem = i & 4095, d = rem >> 6, c = rem & 63; wpt[i] = (bf16)f2bf(p.in[I_CWP][lg * 4096 + c * 64 + d]); }
    }
    {
        const int gid = blockIdx.x * NTHREADS + tid, GT = gridDim.x * NTHREADS;
        float* ssz = (float*)(ws + WS_SS); for (int i = gid; i < 4 * MALL; i += GT) ssz[i] = 0.f;
        const f32x4* cs = (const f32x4*)p.in[I_CTX]; f32x4* xc = (f32x4*)(ws + WS_XC); for (int i = gid; i < MCTX * DM / 4; i += GT) xc[i] = cs[i];
    }
    phase_transposes(p, lds, 0, 0, gridDim.x);
}

__device__ __forceinline__ void phase_norm(const KP& p, int l, int which, const float* src_lat, const float* src_ctx, int row_lo, int row_hi, float* ss) {
    const int lane = threadIdx.x & 63, wave = threadIdx.x >> 6;
    const int gw = blockIdx.x * NWAVES + wave, NGW = gridDim.x * NWAVES;
    const float* mod = (const float*)(p.ws + WS_MOD);
    const float* g = (which ? p.in[I_GFFN] : p.in[I_GMIX]) + l * DM;
    bf16* H = (bf16*)(p.ws + WS_H);
    f32x4 vn[4];
    {   const int row = row_lo + gw;
        if (row < row_hi) { const float* xr = row >= MLAT ? src_ctx + (size_t)(row - MLAT) * DM : src_lat + (size_t)row * DM;
#pragma unroll
            for (int j = 0; j < 4; ++j) vn[j] = *(const f32x4*)(xr + 4 * lane + 256 * j); } }
    for (int row = row_lo + gw; row < row_hi; row += NGW) {
        const bool isc = row >= MLAT;
        const int bb = isc ? 8 : (row >> 11);
        const float* sc = mod + (size_t)(l * 9 + bb) * 6144 + (which ? 4096 : 1024);
        f32x4 v[4]; float q = 0.f;
#pragma unroll
        for (int j = 0; j < 4; ++j) v[j] = vn[j];
        {   const int rn = row + NGW;
            if (rn < row_hi) { const float* xr = rn >= MLAT ? src_ctx + (size_t)(rn - MLAT) * DM : src_lat + (size_t)rn * DM;
#pragma unroll
                for (int j = 0; j < 4; ++j) vn[j] = *(const f32x4*)(xr + 4 * lane + 256 * j); } }
#pragma unroll
        for (int j = 0; j < 4; ++j) q += (v[j].x * v[j].x + v[j].y * v[j].y) + (v[j].z * v[j].z + v[j].w * v[j].w);
        q = wave_sum(q);
        if (lane == 0) ss[row] = q;
#pragma unroll
        for (int j = 0; j < 4; ++j) { const int col = 4 * lane + 256 * j;
            const f32x4 gg = *(const f32x4*)(g + col), sv = *(const f32x4*)(sc + col);
            const f32x4 y = v[j] * gg * (sv + 1.0f);
            u32x2 w; w.x = pk2(y.x, y.y); w.y = pk2(y.z, y.w);
            *(u32x2*)(H + (size_t)row * DM + col) = w; }
    }
}
__device__ __forceinline__ void phase_norm_ctx(const KP& p, int l, int which, int lg, int goff, const float* part, float* ss) {
    const int lane = threadIdx.x & 63, wave = threadIdx.x >> 6;
    const int gw = blockIdx.x * NWAVES + wave, NGW = gridDim.x * NWAVES;
    const float* mod = (const float*)(p.ws + WS_MOD);
    const float* g = (which ? p.in[I_GFFN] : p.in[I_GMIX]) + l * DM;
    const float* sc = mod + (size_t)(l * 9 + 8) * 6144 + (which ? 4096 : 1024);
    const float* gate = mod + (size_t)(lg * 9 + 8) * 6144 + goff;
    bf16* H = (bf16*)(p.ws + WS_H); float* XC = (float*)(p.ws + WS_XC);
    for (int r = gw; r < MCTX; r += NGW) {
        f32x4 v[4]; float q = 0.f;
#pragma unroll
        for (int j = 0; j < 4; ++j) { const size_t off = (size_t)r * DM + 4 * lane + 256 * j; f32x4 a = *(const f32x4*)(part + off);
#pragma unroll
            for (int sl = 1; sl < 8; ++sl) a += *(const f32x4*)(part + (size_t)sl * MCTX * DM + off);
            v[j] = *(const f32x4*)(XC + off) + *(const f32x4*)(gate + 4 * lane + 256 * j) * a;
            *(f32x4*)(XC + off) = v[j];
            q += (v[j].x * v[j].x + v[j].y * v[j].y) + (v[j].z * v[j].z + v[j].w * v[j].w); }
        q = wave_sum(q);
        if (lane == 0) ss[MLAT + r] = q;
#pragma unroll
        for (int j = 0; j < 4; ++j) { const int col = 4 * lane + 256 * j;
            const f32x4 gg = *(const f32x4*)(g + col), sv = *(const f32x4*)(sc + col);
            const f32x4 y = v[j] * gg * (sv + 1.0f);
            u32x2 w; w.x = pk2(y.x, y.y); w.y = pk2(y.z, y.w);
            *(u32x2*)(H + (size_t)(MLAT + r) * DM + col) = w; }
    }
}
__device__ __forceinline__ void phase_tables(const KP& p, unsigned char* lds, int sel) {
    const int tid = threadIdx.x, lane = tid & 63, wave = tid >> 6;
    const int gw = blockIdx.x * NWAVES + wave, NGW = gridDim.x * NWAVES;
    const float* mod = (const float*)(p.ws + WS_MOD);
    float* gs = (float*)(p.ws + WS_GS);
    if (sel == 0) for (int i = blockIdx.x * NTHREADS + tid; i < 2 * 2 * 9 * 1024; i += gridDim.x * NTHREADS) { const int lw = i / 9216, rem = i - lw * 9216, bb = rem >> 10, col = rem & 1023, l = lw >> 1, which = lw & 1;
        const float g = (which ? p.in[I_GFFN] : p.in[I_GMIX])[l * DM + col]; gs[i] = g * (1.0f + mod[(size_t)(l * 9 + bb) * 6144 + (which ? 4096 : 1024) + col]); }
    const int ntask = sel ? 176 : 64;
    for (int task = blockIdx.x; task < ntask; task += gridDim.x) {
        const int which = sel, l = sel ? task / 88 : task / 32, slab = sel ? task - l * 88 : task - l * 32;
        float* sh = (float*)lds;
        __syncthreads();
        for (int i = tid; i < 9 * 1024; i += NTHREADS) sh[i] = mod[(size_t)(l * 9 + (i >> 10)) * 6144 + (which ? 3072 : 0) + (i & 1023)];
        __syncthreads();
        const int Nn = which ? NGU : NIN, n = slab * 64 + lane;
        const bf16* WT = (which ? (const bf16*)(p.ws + WS_WGU) + (size_t)l * NGU * DM : (const bf16*)(p.ws + WS_WIN) + (size_t)l * NIN * DM) + (size_t)n * DM + wave * 128;
        float acc[9];
#pragma unroll
        for (int b = 0; b < 9; ++b) acc[b] = 0.f;
        u32x4 wr[16];
#pragma unroll
        for (int i = 0; i < 16; ++i) wr[i] = *(const u32x4*)(WT + 8 * i);
#pragma unroll
        for (int i = 0; i < 16; ++i) { float wf[8]; wf[0] = bflo(wr[i].x); wf[1] = bfhi(wr[i].x); wf[2] = bflo(wr[i].y); wf[3] = bfhi(wr[i].y); wf[4] = bflo(wr[i].z); wf[5] = bfhi(wr[i].z); wf[6] = bflo(wr[i].w); wf[7] = bfhi(wr[i].w);
#pragma unroll
            for (int b = 0; b < 9; ++b) { const float* sr = sh + b * 1024 + wave * 128 + 8 * i; const f32x4 a0 = *(const f32x4*)(sr), a1 = *(const f32x4*)(sr + 4);
#pragma unroll
                for (int j = 0; j < 4; ++j) acc[b] += wf[j] * a0[j] + wf[4 + j] * a1[j]; } }
        float* red = (float*)(lds + 40960);
#pragma unroll
        for (int b = 0; b < 9; ++b) red[(wave * 9 + b) * 64 + lane] = acc[b];
        __syncthreads();
        float* out = which ? (float*)(p.ws + WS_BIAS2) + (size_t)l * 9 * NGU : (float*)(p.ws + WS_BIAS1) + (size_t)l * 9 * NIN;
        for (int i = tid; i < 576; i += NTHREADS) { const int b = i >> 6, cc = i & 63; float a = 0.f;
#pragma unroll
            for (int wv = 0; wv < 8; ++wv) a += red[(wv * 9 + b) * 64 + cc];
            out[(size_t)b * Nn + slab * 64 + cc] = a; }
    }
    __syncthreads();
}

__device__ __forceinline__ void prep_head(const u32x4 (&raw)[4], const float* gainL, const float* ropeL, int pos, float scale, int h, u32x4 (&out)[4]) {
    float x[4][8]; float ss = 0.f;
#pragma unroll
    for (int c = 0; c < 4; ++c) { x[c][0] = bflo(raw[c].x); x[c][1] = bfhi(raw[c].x); x[c][2] = bflo(raw[c].y); x[c][3] = bfhi(raw[c].y); x[c][4] = bflo(raw[c].z); x[c][5] = bfhi(raw[c].z); x[c][6] = bflo(raw[c].w); x[c][7] = bfhi(raw[c].w);
#pragma unroll
        for (int i = 0; i < 8; ++i) ss += x[c][i] * x[c][i]; }
    ss += __shfl_xor(ss, 32);
    const float rstd = (1.0f / sqrtf(ss * (1.0f / 64.0f) + EPS)) * scale;
#pragma unroll
    for (int c = 0; c < 4; ++c) { const f32x4 g0 = *(const f32x4*)(gainL + 16 * c + 8 * h), g1 = *(const f32x4*)(gainL + 16 * c + 8 * h + 4);
#pragma unroll
        for (int i = 0; i < 4; ++i) { x[c][i] *= rstd * g0[i]; x[c][4 + i] *= rstd * g1[i]; } }
    if (pos >= 0) {
        const int pr = pos >> 6, pc = pos & 63;
#pragma unroll
        for (int ax = 0; ax < 2; ++ax) { const float* tb = ropeL + ((ax ? pc : pr) * 16 + 8 * h) * 2;
#pragma unroll
            for (int i4 = 0; i4 < 4; ++i4) { const f32x4 cs = *(const f32x4*)(tb + 4 * i4);
#pragma unroll
                for (int e = 0; e < 2; ++e) { const int i = 2 * i4 + e; const float co = cs[2 * e], sn = cs[2 * e + 1]; const float a = x[2 * ax][i], b = x[2 * ax + 1][i];
                    x[2 * ax][i] = a * co - b * sn; x[2 * ax + 1][i] = a * sn + b * co; } } }
    }
#pragma unroll
    for (int c = 0; c < 4; ++c) { out[c].x = pk2(x[c][0], x[c][1]); out[c].y = pk2(x[c][2], x[c][3]); out[c].z = pk2(x[c][4], x[c][5]); out[c].w = pk2(x[c][6], x[c][7]); }
}
__device__ __forceinline__ void phase_prep(const KP& p, int l) {
    const int lane = threadIdx.x & 63, wave = threadIdx.x >> 6, ql = lane & 31, h = lane >> 5;
    const int gw = blockIdx.x * NWAVES + wave, NGW = gridDim.x * NWAVES;
    bf16* P = (bf16*)(p.ws + WS_P); const float* rope = (const float*)(p.ws + WS_ROPE);
    for (int it = gw; it < (MALL / 32) * 14; it += NGW) {
        const int rb = it / 14, slot = it % 14; const int row = rb * 32 + ql;
        int col; const float* gain; bool isq, ropeok;
        if (slot < 4) { col = 64 * slot; gain = p.in[I_AQG] + l * 64; isq = true; ropeok = true; }
        else if (slot < 6) { col = 256 + 64 * (slot - 4); gain = p.in[I_AKG] + l * 64; isq = false; ropeok = true; }
        else if (slot < 10) { col = 1280 + 64 * (slot - 6); gain = p.in[I_DQG] + l * 64; isq = true; ropeok = false; }
        else { col = 1536 + 64 * (slot - 10); gain = p.in[I_DKG] + l * 64; isq = false; ropeok = false; }
        const int pos = (ropeok && row < MLAT) ? (row & (SEQ - 1)) : -1;
        bf16* ptr = P + (size_t)row * NIN + col + 8 * h;
        u32x4 raw[4], o[4];
#pragma unroll
        for (int c = 0; c < 4; ++c) raw[c] = *(const u32x4*)(ptr + 16 * c);
        prep_head(raw, gain, rope, pos, isq ? 0.125f * LOG2E : 1.0f, h, o);
#pragma unroll
        for (int c = 0; c < 4; ++c) *(u32x4*)(ptr + 16 * c) = o[c];
    }
}

constexpr int A_KB = 0, A_KB_SZ = 64 * 144, A_VB = 2 * A_KB_SZ, A_VB_SZ = 64 * 144, A_RPB = A_VB + 2 * A_VB_SZ, A_TAB = A_RPB + 2048, A_END = A_TAB + 256 * 144;

template <int TYPE>
__device__ __forceinline__ void attn_unit(const KP& p, unsigned char* lds, int l, int uidx) {
    int tid_ = threadIdx.x; asm volatile("" : "+v"(tid_));
    const int tid = tid_, lane = tid & 63, wave = __builtin_amdgcn_readfirstlane(tid >> 6), ql = lane & 31, h = lane >> 5;
    const bf16* P = (const bf16*)(p.ws + WS_P); bf16* MIX = (bf16*)(p.ws + WS_MIX);
    int b, qcol, kcol, vcol, ocol, qrow, qpos = 0, NT = 4; float m_i = -1e30f, l_i = 0.f;
    int n = 0, t_lo = 0, wq = 0;
    int hd = 0, c0 = 0, kr_lo = 0, qr = 0, qc = 0, rs_q = 0, cs_q = 0, rsa = 0, rsb = 0, cbq = 0;
    if (TYPE == 0) {
        b = uidx >> 5; const int kh = (uidx >> 4) & 1; n = uidx & 15; const int gi = wave >> 2; wq = wave & 3; const int hq = 2 * kh + gi;
        qpos = n * 128 + 32 * wq + ql; qrow = b * SEQ + qpos; qcol = 64 * hq; kcol = 256 + 64 * kh; vcol = 384 + 64 * kh; ocol = 64 * hq;
        t_lo = (n == 0) ? 2 : 0; const int t_hi = (n == 15) ? 4 : 6; NT = 4 + t_hi - t_lo;
        m_i = p.in[I_ASINK][l * 4 + hq] * LOG2E; l_i = h == 0 ? 1.0f : 0.0f;
    } else if (TYPE == 1) {
        b = uidx >> 5; hd = (uidx >> 3) & 3; const int cb = (uidx >> 1) & 3, rh = uidx & 1; const int ra = 16 * rh + 2 * wave; cbq = cb;
        qr = ra + (ql >> 4); qc = 16 * cb + (ql & 15); qpos = qr * 64 + qc; qrow = b * SEQ + qpos;
        qcol = 1280 + 64 * hd; kcol = 1536 + 64 * hd; vcol = 1792 + 64 * hd; ocol = 768 + 64 * hd;
        c0 = cb == 0 ? 0 : (cb == 1 ? 8 : (cb == 2 ? 24 : 32)); kr_lo = rh ? 12 : 0; NT = 4 + 10;
        rs_q = min(max(qr - 4, 0), 24); cs_q = min(max(qc - 8, 0), 48); rsa = min(max(ra - 4, 0), 24); rsb = min(max(ra - 3, 0), 24);
    } else {
        if (uidx < 32) { b = uidx >> 2; const int kh = (uidx >> 1) & 1, gi = uidx & 1, hq = 2 * kh + gi; qcol = 64 * hq; kcol = 256 + 64 * kh; vcol = 384 + 64 * kh; ocol = 64 * hq;
            m_i = p.in[I_ASINK][l * 4 + hq] * LOG2E; l_i = h == 0 ? 1.0f : 0.0f; }
        else { const int uu = uidx - 32; b = uu >> 2; hd = uu & 3; qcol = 1280 + 64 * hd; kcol = 1536 + 64 * hd; vcol = 1792 + 64 * hd; ocol = 768 + 64 * hd; }
        qrow = MLAT + b * CTXL + 32 * wave + ql;
    }
    const int ctx_row0 = MLAT + b * CTXL;
    float* rpbL = (float*)(lds + A_RPB);
    float* tab = (float*)(lds + A_TAB);
    if (TYPE == 1) {
        const int ro = tid >> 5, qcl = (tid >> 1) & 15, hf = tid & 1; const int qcc = 16 * cbq + qcl, csq = min(max(qcc - 8, 0), 48);
        const float* rb = p.in[I_RPB] + (size_t)(l * 4 + hd) * 465 + ro * 31 + 15 - qcc;
        float* dst = tab + (ro * 16 + qcl) * 36 + 16 * hf;
#pragma unroll
        for (int j = 0; j < 16; ++j) { const int kc = c0 + 16 * hf + j; const bool ok = (ro < 15) && ((unsigned)(kc - csq) < 16u); float v = -1e30f; if (ok) v = rb[kc] * LOG2E; dst[j] = v; }
    }
    bf16x8 qf[4];
#pragma unroll
    for (int c = 0; c < 4; ++c) qf[c] = *(const bf16x8*)(P + (size_t)qrow * NIN + qcol + 16 * c + 8 * h);
    const int skey = tid & 63, sch = tid >> 6, sk31 = skey & 31;
    const int vpos = 32 * (skey >> 5) + 16 * (sk31 >> 4) + 8 * ((sk31 >> 2) & 1) + 4 * ((sk31 >> 3) & 1) + (sk31 & 3);
    u32x4 kraw, vraw;
#define TILE_ROW(t, krow_) do { if ((t) < 4) krow_ = ctx_row0 + 64 * (t) + skey; \
        else if (TYPE == 0) krow_ = b * SEQ + (n - 1) * 128 + 64 * (t_lo + (t) - 4) + skey; \
        else krow_ = b * SEQ + (kr_lo + 2 * ((t) - 4) + (skey >> 5)) * 64 + c0 + sk31; } while (0)
#define STAGE_LOAD(t) do { int krow_; TILE_ROW(t, krow_); kraw = *(const u32x4*)(P + (size_t)krow_ * NIN + kcol + 8 * sch); vraw = *(const u32x4*)(P + (size_t)krow_ * NIN + vcol + 8 * sch); } while (0)
#define STAGE_STORE(buf) do { *(u32x4*)(lds + A_KB + (buf) * A_KB_SZ + skey * 144 + sch * 16) = kraw; \
        unsigned short* vb_ = (unsigned short*)(lds + A_VB + (buf) * A_VB_SZ) + (8 * sch) * 72 + vpos; \
        vb_[0 * 72] = (unsigned short)(vraw.x & 0xffffu); vb_[1 * 72] = (unsigned short)(vraw.x >> 16); vb_[2 * 72] = (unsigned short)(vraw.y & 0xffffu); vb_[3 * 72] = (unsigned short)(vraw.y >> 16); \
        vb_[4 * 72] = (unsigned short)(vraw.z & 0xffffu); vb_[5 * 72] = (unsigned short)(vraw.z >> 16); vb_[6 * 72] = (unsigned short)(vraw.w & 0xffffu); vb_[7 * 72] = (unsigned short)(vraw.w >> 16); } while (0)
    STAGE_LOAD(0);
    STAGE_STORE(0);
    __syncthreads();
    f32x16 O0, O1;
#pragma unroll
    for (int i = 0; i < 16; ++i) { O0[i] = 0.f; O1[i] = 0.f; }
    for (int t = 0; t < NT; ++t) {
        const int cur = t & 1; const bool more = (t + 1) < NT;
        if (more) STAGE_LOAD(t + 1);
        bool need = true;
        if (t >= 4) { if (TYPE == 0) { const int j0 = 2 * (t_lo + t - 4); need = (j0 + 1 >= wq) && (j0 <= wq + 8); } else if (TYPE == 1) { const int kr = kr_lo + 2 * (t - 4); need = (kr + 1 >= rsa) && (kr < rsb + 8); } }
        if (need) {
            f32x16 s0, s1;
#pragma unroll
            for (int i = 0; i < 16; ++i) { s0[i] = 0.f; s1[i] = 0.f; }
            const unsigned char* kb = lds + A_KB + cur * A_KB_SZ + ql * 144 + h * 16;
#pragma unroll
            for (int c = 0; c < 4; ++c) { s0 = mfma32(*(const bf16x8*)(kb + 32 * c), qf[c], s0); s1 = mfma32(*(const bf16x8*)(kb + 32 * 144 + 32 * c), qf[c], s1); }
            if (t >= 4) {
                if (TYPE == 0) { const int kp0 = (n - 1) * 128 + 64 * (t_lo + t - 4) + 4 * h - qpos; const int kq0 = (n - 1) * 128 + 64 * (t_lo + t - 4) - (n * 128 + 32 * wq);
                  if (kq0 < 31 - 128 || kq0 + 63 > 128)
#pragma unroll
                    for (int i = 0; i < 16; ++i) { const unsigned du = (unsigned)(kp0 + 128) + (unsigned)(8 * (i >> 2) + (i & 3));
                        s0[i] = (du <= 256u) ? s0[i] : -1e30f; s1[i] = (du + 32u <= 256u) ? s1[i] : -1e30f; } }
                else if (TYPE == 1) { const int kr = kr_lo + 2 * (t - 4);
                    const int ro0 = ((unsigned)(kr - rs_q) < 8u) ? (kr - qr + 7) : 15, ro1 = ((unsigned)(kr + 1 - rs_q) < 8u) ? (kr + 1 - qr + 7) : 15;
                    const float* t0 = tab + (ro0 * 16 + (ql & 15)) * 36 + 4 * h; const float* t1 = tab + (ro1 * 16 + (ql & 15)) * 36 + 4 * h;
#pragma unroll
                    for (int g = 0; g < 4; ++g) { const f32x4 a = *(const f32x4*)(t0 + 8 * g), bq = *(const f32x4*)(t1 + 8 * g);
#pragma unroll
                        for (int j = 0; j < 4; ++j) { s0[4 * g + j] += a[j]; s1[4 * g + j] += bq[j]; } } }
            }
            const float PINF = __builtin_inff();
            float mxa = __builtin_amdgcn_fmed3f(s0[0], s0[1], PINF), mxb = __builtin_amdgcn_fmed3f(s0[8], s0[9], PINF), mxc = __builtin_amdgcn_fmed3f(s1[0], s1[1], PINF), mxd = __builtin_amdgcn_fmed3f(s1[8], s1[9], PINF);
#pragma unroll
            for (int i = 2; i < 8; ++i) { mxa = __builtin_amdgcn_fmed3f(mxa, s0[i], PINF); mxb = __builtin_amdgcn_fmed3f(mxb, s0[8 + i], PINF); mxc = __builtin_amdgcn_fmed3f(mxc, s1[i], PINF); mxd = __builtin_amdgcn_fmed3f(mxd, s1[8 + i], PINF); }
            float mx = __builtin_amdgcn_fmed3f(__builtin_amdgcn_fmed3f(mxa, mxb, PINF), __builtin_amdgcn_fmed3f(mxc, mxd, PINF), PINF);
            mx = fmaxf(mx, __shfl_xor(mx, 32));
            const float mn = fmaxf(m_i, mx); const float alpha = __builtin_amdgcn_exp2f(m_i - mn); m_i = mn;
            float la = 0.f, lb = 0.f, lc = 0.f, ld = 0.f;
#pragma unroll
            for (int i = 0; i < 16; i += 2) { s0[i] = __builtin_amdgcn_exp2f(s0[i] - mn); s0[i + 1] = __builtin_amdgcn_exp2f(s0[i + 1] - mn); s1[i] = __builtin_amdgcn_exp2f(s1[i] - mn); s1[i + 1] = __builtin_amdgcn_exp2f(s1[i + 1] - mn);
                la += s0[i]; lb += s0[i + 1]; lc += s1[i]; ld += s1[i + 1]; }
            l_i = l_i * alpha + ((la + lb) + (lc + ld));
            if (__builtin_amdgcn_ballot_w64(alpha != 1.0f) != 0ull) {
#pragma unroll
                for (int i = 0; i < 16; ++i) { O0[i] *= alpha; O1[i] *= alpha; } }
            u32x4 pw0, pw1, pw2, pw3;
            pw0.x = pk2(s0[0], s0[1]); pw0.y = pk2(s0[2], s0[3]); pw0.z = pk2(s0[4], s0[5]); pw0.w = pk2(s0[6], s0[7]);
            pw1.x = pk2(s0[8], s0[9]); pw1.y = pk2(s0[10], s0[11]); pw1.z = pk2(s0[12], s0[13]); pw1.w = pk2(s0[14], s0[15]);
            pw2.x = pk2(s1[0], s1[1]); pw2.y = pk2(s1[2], s1[3]); pw2.z = pk2(s1[4], s1[5]); pw2.w = pk2(s1[6], s1[7]);
            pw3.x = pk2(s1[8], s1[9]); pw3.y = pk2(s1[10], s1[11]); pw3.z = pk2(s1[12], s1[13]); pw3.w = pk2(s1[14], s1[15]);
            const bf16x8 pf0 = as_bf16x8(pw0), pf1 = as_bf16x8(pw1), pf2 = as_bf16x8(pw2), pf3 = as_bf16x8(pw3);
            const unsigned char* vb = lds + A_VB + cur * A_VB_SZ + ql * 144 + h * 16;
            O0 = mfma32(*(const bf16x8*)(vb), pf0, O0); O0 = mfma32(*(const bf16x8*)(vb + 32), pf1, O0); O0 = mfma32(*(const bf16x8*)(vb + 64), pf2, O0); O0 = mfma32(*(const bf16x8*)(vb + 96), pf3, O0);
            O1 = mfma32(*(const bf16x8*)(vb + 32 * 144), pf0, O1); O1 = mfma32(*(const bf16x8*)(vb + 32 * 144 + 32), pf1, O1); O1 = mfma32(*(const bf16x8*)(vb + 32 * 144 + 64), pf2, O1); O1 = mfma32(*(const bf16x8*)(vb + 32 * 144 + 96), pf3, O1);
        }
        if (more) STAGE_STORE(cur ^ 1);
        __syncthreads();
    }
#undef TILE_ROW
#undef STAGE_LOAD
#undef STAGE_STORE
    const float lt = l_i + __shfl_xor(l_i, 32); const float inv = 1.0f / lt;
    bf16* orow = MIX + (size_t)qrow * DM + ocol + 4 * h;
#pragma unroll
    for (int g4 = 0; g4 < 4; ++g4) {
        u32x2 w0, w1; w0.x = pk2(O0[4 * g4] * inv, O0[4 * g4 + 1] * inv); w0.y = pk2(O0[4 * g4 + 2] * inv, O0[4 * g4 + 3] * inv);
        w1.x = pk2(O1[4 * g4] * inv, O1[4 * g4 + 1] * inv); w1.y = pk2(O1[4 * g4 + 2] * inv, O1[4 * g4 + 3] * inv);
        *(u32x2*)(orow + 8 * g4) = w0; *(u32x2*)(orow + 32 + 8 * g4) = w1; }
}

__device__ __forceinline__ void sgu_unit(const KP& p, unsigned char* lds, int l, int R0) {
    int tid_ = threadIdx.x; asm volatile("" : "+v"(tid_));
    const int tid = tid_, lane = tid & 63, wave = __builtin_amdgcn_readfirstlane(tid >> 6), ql = lane & 31, h = lane >> 5;
    const bf16* P = (const bf16*)(p.ws + WS_P); bf16* MIX = (bf16*)(p.ws + WS_MIX);
    constexpr int VP = 136;
    unsigned short* Vt = (unsigned short*)lds;
    {
        const int token = tid >> 2, qtr = tid & 3;
        const u32x4* src = (const u32x4*)(P + (size_t)(R0 + token) * NIN + 768 + 64 * qtr);
        float v[64]; float s = 0.f;
#pragma unroll
        for (int j = 0; j < 8; ++j) { const u32x4 r = src[j];
            v[8 * j + 0] = gelu_tanh(bflo(r.x)); v[8 * j + 1] = gelu_tanh(bfhi(r.x)); v[8 * j + 2] = gelu_tanh(bflo(r.y)); v[8 * j + 3] = gelu_tanh(bfhi(r.y));
            v[8 * j + 4] = gelu_tanh(bflo(r.z)); v[8 * j + 5] = gelu_tanh(bfhi(r.z)); v[8 * j + 6] = gelu_tanh(bflo(r.w)); v[8 * j + 7] = gelu_tanh(bfhi(r.w)); }
#pragma unroll
        for (int i = 0; i < 64; ++i) s += v[i];
        s += __shfl_xor(s, 1); s += __shfl_xor(s, 2);
        const float mu = s * (1.0f / 256.0f); float q = 0.f;
#pragma unroll
        for (int i = 0; i < 64; ++i) { v[i] -= mu; q += v[i] * v[i]; }
        q += __shfl_xor(q, 1); q += __shfl_xor(q, 2);
        const float rstd = 1.0f / sqrtf(q * (1.0f / 256.0f) + EPS);
        const float* gn = p.in[I_BVG] + l * 256 + 64 * qtr;
#pragma unroll
        for (int i = 0; i < 64; ++i) Vt[(64 * qtr + i) * VP + token] = (unsigned short)f2bf(v[i] * rstd * gn[i]);
    }
    __syncthreads();
    const int g = wave >> 1, ph = wave & 1;
    f32x16 acc[2][2];
#pragma unroll
    for (int a = 0; a < 2; ++a)
#pragma unroll
        for (int c = 0; c < 2; ++c)
#pragma unroll
            for (int i = 0; i < 16; ++i) acc[a][c][i] = 0.f;
    const bf16* Wg = (const bf16*)(p.ws + WS_WSBF) + (size_t)(l * 4 + g) * 128 * 128;
#pragma unroll 2
    for (int s = 0; s < 8; ++s) {
        bf16x8 a[2], bq[2];
#pragma unroll
        for (int mb = 0; mb < 2; ++mb) a[mb] = *(const bf16x8*)(Vt + (64 * g + 32 * mb + ql) * VP + 16 * s + 8 * h);
#pragma unroll
        for (int nb = 0; nb < 2; ++nb) bq[nb] = *(const bf16x8*)(Wg + (64 * ph + 32 * nb + ql) * 128 + 16 * s + 8 * h);
#pragma unroll
        for (int mb = 0; mb < 2; ++mb)
#pragma unroll
            for (int nb = 0; nb < 2; ++nb) acc[mb][nb] = mfma32(a[mb], bq[nb], acc[mb][nb]);
    }
    u32x2 upre[2][2][4]; float bpre[2];
#pragma unroll
    for (int nb = 0; nb < 2; ++nb) { const int pp = 64 * ph + 32 * nb + ql; const size_t row = (size_t)(R0 + pp); bpre[nb] = p.in[I_BBS][(l * 4 + g) * 128 + pp];
#pragma unroll
        for (int mb = 0; mb < 2; ++mb)
#pragma unroll
            for (int g4 = 0; g4 < 4; ++g4) upre[nb][mb][g4] = *(const u32x2*)(P + row * NIN + 512 + 64 * g + 32 * mb + 8 * g4 + 4 * h); }
#pragma unroll
    for (int nb = 0; nb < 2; ++nb) { const int pp = 64 * ph + 32 * nb + ql; const size_t row = (size_t)(R0 + pp); const float bias = bpre[nb];
#pragma unroll
        for (int mb = 0; mb < 2; ++mb)
#pragma unroll
            for (int g4 = 0; g4 < 4; ++g4) { const int c = 64 * g + 32 * mb + 8 * g4 + 4 * h;
                const u32x2 ur = upre[nb][mb][g4];
                const float o0 = gelu_tanh(bflo(ur.x)) * (acc[mb][nb][4 * g4 + 0] + bias), o1 = gelu_tanh(bfhi(ur.x)) * (acc[mb][nb][4 * g4 + 1] + bias);
                const float o2 = gelu_tanh(bflo(ur.y)) * (acc[mb][nb][4 * g4 + 2] + bias), o3 = gelu_tanh(bfhi(ur.y)) * (acc[mb][nb][4 * g4 + 3] + bias);
                u32x2 w; w.x = pk2(o0, o1); w.y = pk2(o2, o3);
                *(u32x2*)(MIX + row * DM + 256 + c) = w; } }
    __syncthreads();
}

__device__ __forceinline__ void pool_unit(const KP& p, unsigned char* lds, int l, int segrow, int nseg, int t0) {
    int tid_ = threadIdx.x; asm volatile("" : "+v"(tid_));
    const int tid = tid_, lane = tid & 63, wave = __builtin_amdgcn_readfirstlane(tid >> 6), ql = lane & 31, h = lane >> 5;
    const bf16* P = (const bf16*)(p.ws + WS_P); bf16* MIX = (bf16*)(p.ws + WS_MIX);
    constexpr int RP = 528;
    for (int i = tid; i < 144 * 32; i += NTHREADS) { const int r = i >> 5, ch = i & 31, t = t0 - 8 + r; u32x4 val = (u32x4){0u, 0u, 0u, 0u};
        if (t >= 0 && t < nseg) val = *(const u32x4*)(P + (size_t)(segrow + t) * NIN + 1024 + 8 * ch);
        *(u32x4*)(lds + r * RP + ch * 16) = val; }
    __syncthreads();
    const int tb = wave & 3, gp = wave >> 2, tl = 32 * tb + ql, t = t0 + tl;
    const size_t row = (size_t)(segrow + t);
    for (int gs = 0; gs < 2; ++gs) {
        const int gi = 2 * gp + gs, half = 1 << gi;
        const int lo = max(t - half, 0), hi = min(t + half, nseg); const float inv = 1.0f / (float)(hi - lo);
        f32x16 acc[2];
#pragma unroll
        for (int a = 0; a < 2; ++a)
#pragma unroll
            for (int i = 0; i < 16; ++i) acc[a][i] = 0.f;
        const bf16* Wp = (const bf16*)(p.ws + WS_WPT) + (size_t)(l * 4 + gi) * 64 * 64;
        for (int s = 0; s < 4; ++s) {
            const unsigned char* base = lds + (tl + 8) * RP + (64 * gi + 16 * s + 8 * h) * 2;
            float sm[8];
#pragma unroll
            for (int i = 0; i < 8; ++i) sm[i] = 0.f;
            for (int r = -half; r < half; ++r) { const u32x4 v = *(const u32x4*)(base + r * RP);
                sm[0] += bflo(v.x); sm[1] += bfhi(v.x); sm[2] += bflo(v.y); sm[3] += bfhi(v.y); sm[4] += bflo(v.z); sm[5] += bfhi(v.z); sm[6] += bflo(v.w); sm[7] += bfhi(v.w); }
            const u32x4 sv = *(const u32x4*)(base);
            u32x4 w; w.x = pk2(sm[0] * inv - bflo(sv.x), sm[1] * inv - bfhi(sv.x)); w.y = pk2(sm[2] * inv - bflo(sv.y), sm[3] * inv - bfhi(sv.y));
            w.z = pk2(sm[4] * inv - bflo(sv.z), sm[5] * inv - bfhi(sv.z)); w.w = pk2(sm[6] * inv - bflo(sv.w), sm[7] * inv - bfhi(sv.w));
            const bf16x8 bfr = as_bf16x8(w);
#pragma unroll
            for (int mb = 0; mb < 2; ++mb) { const bf16x8 a = *(const bf16x8*)(Wp + (32 * mb + ql) * 64 + 16 * s + 8 * h); acc[mb] = mfma32(a, bfr, acc[mb]); }
        }
        f32x4 scp[2][4];
#pragma unroll
        for (int mb = 0; mb < 2; ++mb)
#pragma unroll
            for (int g4 = 0; g4 < 4; ++g4) scp[mb][g4] = *(const f32x4*)(p.in[I_CSC] + l * 256 + 64 * gi + 32 * mb + 8 * g4 + 4 * h);
#pragma unroll
        for (int mb = 0; mb < 2; ++mb)
#pragma unroll
            for (int g4 = 0; g4 < 4; ++g4) { const int d = 32 * mb + 8 * g4 + 4 * h; const f32x4 sc = scp[mb][g4];
                u32x2 w; w.x = pk2(acc[mb][4 * g4] * sc.x, acc[mb][4 * g4 + 1] * sc.y); w.y = pk2(acc[mb][4 * g4 + 2] * sc.z, acc[mb][4 * g4 + 3] * sc.w);
                *(u32x2*)(MIX + row * DM + 512 + 64 * gi + d) = w; }
    }
    __syncthreads();
}

__device__ __forceinline__ void phase_mixer(const KP& p, unsigned char* lds, int l, const XcdBarrier& bar) {
    for (int u = blockIdx.x; u < 768; u += gridDim.x) {
        if (u < 256) attn_unit<1>(p, lds, l, u);
        else if (u < 512) attn_unit<0>(p, lds, l, u - 256);
        else if (u < 640) sgu_unit(p, lds, l, (u - 512) * 128);
        else { const int ch = u - 640; pool_unit(p, lds, l, (ch >> 4) * SEQ, SEQ, (ch & 15) * 128); }
    }
    if (l == 0) {
        const int G = (int)gridDim.x, first = G > 96 ? G - 96 : 0;
        for (int cu = (int)blockIdx.x - first; cu < 96; cu += G) { if (cu < 0) continue;
            if (cu < 64) attn_unit<2>(p, lds, l, cu);
            else if (cu < 80) sgu_unit(p, lds, l, MLAT + (cu - 64) * 128);
            else { const int ch = cu - 80; pool_unit(p, lds, l, MLAT + (ch >> 1) * CTXL, CTXL, (ch & 1) * 128); } }
    }
}

template <int L>
__device__ __forceinline__ void ph_g1(unsigned char* lds, const float* ss) {
    const KP p = make_kp(); unsigned char* ws = p.ws;
    pg8::Gemm g{(const pg8::bf16_t*)(ws + WS_H), (const pg8::bf16_t*)(ws + WS_WIN) + (size_t)L * NIN * DM, MALL, NIN, DM, DM}; pg8::StaticOrder S; S.init(MALL, NIN, gridDim.x, blockIdx.x);
    {   const f32x4* rsrc = (const f32x4*)(ws + WS_ROPE); LAS f32x4* rdst = (LAS f32x4*)((LAS unsigned char*)lds + LDS_ROPE);
        rdst[threadIdx.x] = rsrc[threadIdx.x]; __syncthreads(); }
    EpiG1 E{(bf16*)(ws + WS_P), ss, (const float*)(ws + WS_BIAS1) + (size_t)L * 9 * NIN, p.in[I_AQG] + L * 64, p.in[I_AKG] + L * 64, p.in[I_DQG] + L * 64, p.in[I_DKG] + L * 64, (const LAS float*)((LAS unsigned char*)lds + LDS_ROPE)};
    pg8::gemm_phase<EpiG1, pg8::StaticOrder, true, true>((PG8_LAS unsigned char*)lds, g, S, E);
    if (L == 0) {
        const KP p2 = make_kp(); const int G = (int)gridDim.x, nwg = (MALL / 256) * (NIN / 256), rem = nwg % G;
        __syncthreads();
        phase_transposes(p2, lds, 1, rem, G - rem);
    }
}
template <int L>
__device__ __forceinline__ void ph_g2(unsigned char* lds, float* ss) {
    const KP p = make_kp(); unsigned char* ws = p.ws;
    {   pg8::Gemm g{(const pg8::bf16_t*)(ws + WS_MIX), (const pg8::bf16_t*)(ws + WS_WOUT) + (size_t)L * DM * DM, MLAT, DM, DM, DM}; pg8::StaticOrder S; S.init(MLAT, DM, gridDim.x, blockIdx.x);
        EpiResGate<true> E{L == 0 ? p.in[I_X] : p.out, p.out, (const float*)(ws + WS_MOD) + (size_t)L * 9 * 6144 + 2048, (bf16*)(ws + WS_H), ss, (const float*)(ws + WS_GS) + (size_t)(L * 2 + 1) * 9 * 1024};
        pg8::gemm_phase<EpiResGate<true>, pg8::StaticOrder, true, true>((PG8_LAS unsigned char*)lds, g, S, E); }
    if (L == 0) {
        pg8::Gemm g{(const pg8::bf16_t*)(ws + WS_MIX) + (size_t)MLAT * DM, (const pg8::bf16_t*)(ws + WS_WOUT) + (size_t)L * DM * DM, MCTX, DM, 128, DM}; SplitKOrder S; S.init(MCTX / 256, DM / 256, 8, gridDim.x, blockIdx.x, 0);
        EpiPartial E{(float*)(ws + WS_PART2), 0};
        pg8::gemm_phase<EpiPartial, SplitKOrder, true, true>((PG8_LAS unsigned char*)lds, g, S, E); }
}
template <int L>
__device__ __forceinline__ void ph_g3(unsigned char* lds, const float* ss) {
    const KP p = make_kp(); unsigned char* ws = p.ws;
    constexpr int M = (L == 0) ? MALL : MLAT;
    pg8::Gemm g{(const pg8::bf16_t*)(ws + WS_H), (const pg8::bf16_t*)(ws + WS_WGU) + (size_t)L * NGU * DM, M, NGU, DM, DM}; pg8::StaticOrder S; S.init(M, NGU, gridDim.x, blockIdx.x);
    EpiSwiglu E{(bf16*)(ws + WS_HID), ss, (const float*)(ws + WS_BIAS2) + (size_t)L * 9 * NGU};
    pg8::gemm_phase<EpiSwiglu, pg8::StaticOrder, true, true>((PG8_LAS unsigned char*)lds, g, S, E);
}
template <int L>
__device__ __forceinline__ void ph_g4(unsigned char* lds, float* ss) {
    const KP p = make_kp(); unsigned char* ws = p.ws;
    {   pg8::Gemm g{(const pg8::bf16_t*)(ws + WS_HID), (const pg8::bf16_t*)(ws + WS_WD) + (size_t)L * DM * FF, MLAT, DM, FF, FF}; pg8::StaticOrder S; S.init(MLAT, DM, gridDim.x, blockIdx.x);
        EpiResGate<L == 0> E{p.out, p.out, (const float*)(ws + WS_MOD) + (size_t)L * 9 * 6144 + 5120, (bf16*)(ws + WS_H), ss, (const float*)(ws + WS_GS) + (size_t)(1 * 2 + 0) * 9 * 1024};
        pg8::gemm_phase<EpiResGate<L == 0>, pg8::StaticOrder, true, true>((PG8_LAS unsigned char*)lds, g, S, E); }
    if (L == 0) {
        {   pg8::Gemm g{(const pg8::bf16_t*)(ws + WS_HID) + (size_t)MLAT * FF, (const pg8::bf16_t*)(ws + WS_WD) + (size_t)L * DM * FF, MCTX, DM, 384, FF}; SplitKOrder S; S.init(MCTX / 256, DM / 256, 6, gridDim.x, blockIdx.x, 0);
            EpiPartial E{(float*)(ws + WS_PART4), 0};
            pg8::gemm_phase<EpiPartial, SplitKOrder, true, true>((PG8_LAS unsigned char*)lds, g, S, E); }
        {   pg8::Gemm g{(const pg8::bf16_t*)(ws + WS_HID) + (size_t)MLAT * FF + 2304, (const pg8::bf16_t*)(ws + WS_WD) + (size_t)L * DM * FF + 2304, MCTX, DM, 256, FF}; SplitKOrder S; S.init(MCTX / 256, DM / 256, 2, gridDim.x, blockIdx.x, 192);
            EpiPartial E{(float*)(ws + WS_PART4), 6};
            pg8::gemm_phase<EpiPartial, SplitKOrder, true, true>((PG8_LAS unsigned char*)lds, g, S, E); } }
}
#define PH_IN(k) (lo <= (k) && (k) < hi)
#define PH_SYNC(k) do { if (lo <= (k) && (k) + 1 < hi) xcd_barrier(bar); } while (0)
__global__ void __launch_bounds__(NTHREADS, 2) fwd_kernel(Params p) {
    extern __shared__ __attribute__((aligned(16))) unsigned char lds[];
    cg::grid_group grid = cg::this_grid();
    const int lo = p.ph_lo, hi = p.ph_hi;
    volatile LAS unsigned* bst = (volatile LAS unsigned*)((LAS unsigned char*)lds + 131072 + 64);
    if (threadIdx.x < 2) bst[threadIdx.x] = 0u;
    unsigned* barw = (unsigned*)(p.ws + WS_BAR);
    if (PH_IN(0)) {
        const KP kp = make_kp(); phase_prologue(kp, lds);
    }
    if (hi > 1000) grid.sync();
    XcdBarrier bar = xcd_barrier_post(barw, bst);
    __syncthreads();
    PH_SYNC(0);
    float* SS = (float*)(p.ws + WS_SS);
    if (PH_IN(1)) { const KP kp = make_kp(); phase_norm(kp, 0, 0, kp.in[I_X], kp.in[I_CTX], 0, MALL, SS); phase_tables(kp, lds, 0); }
    PH_SYNC(1);
    if (PH_IN(2)) ph_g1<0>(lds, SS);
    PH_SYNC(2);
    if (PH_IN(3)) { const KP kp = make_kp(); phase_mixer(kp, lds, 0, bar); }
    PH_SYNC(3);
    if (PH_IN(4)) ph_g2<0>(lds, SS + MALL);
    PH_SYNC(4);
    if (PH_IN(5)) { const KP kp = make_kp(); phase_norm_ctx(kp, 0, 1, 0, 2048, (const float*)(kp.ws + WS_PART2), SS + MALL); phase_tables(kp, lds, 1); }
    PH_SYNC(5);
    if (PH_IN(6)) ph_g3<0>(lds, SS + MALL);
    PH_SYNC(6);
    if (PH_IN(7)) ph_g4<0>(lds, SS + 2 * MALL);
    PH_SYNC(7);
    if (PH_IN(8)) { const KP kp = make_kp(); phase_norm_ctx(kp, 1, 0, 0, 5120, (const float*)(kp.ws + WS_PART4), SS + 2 * MALL); }
    PH_SYNC(8);
    if (PH_IN(9)) ph_g1<1>(lds, SS + 2 * MALL);
    PH_SYNC(9);
    if (PH_IN(10)) { const KP kp = make_kp(); phase_mixer(kp, lds, 1, bar); }
    PH_SYNC(10);
    if (PH_IN(11)) ph_g2<1>(lds, SS + 3 * MALL);
    PH_SYNC(11);
    if (PH_IN(12)) ph_g3<1>(lds, SS + 3 * MALL);
    PH_SYNC(12);
    if (PH_IN(13)) ph_g4<1>(lds, nullptr);
}
}

#ifndef MK_MULTI
#define MK_MULTI 0
#endif
extern "C" void kernel_launch(void* const* d_in, const int* in_sizes, int n_in, void* d_out, int out_size, void* d_ws, size_t ws_size, hipStream_t stream) {
    using namespace mk;
    static int grid = 0;
    if (grid == 0) {
        if (n_in != 24 || out_size != MLAT * DM || ws_size < WS_END) { fprintf(stderr, "kernel_launch: unexpected problem (n_in %d out %d ws %zu need %zu)\n", n_in, out_size, ws_size, (size_t)WS_END); grid = -1; return; }
        int dev = 0, cus = 0, per_cu = 0;
        hipGetDevice(&dev); hipDeviceGetAttribute(&cus, hipDeviceAttributeMultiprocessorCount, dev);
        if (hipFuncSetAttribute((const void*)fwd_kernel, hipFuncAttributeMaxDynamicSharedMemorySize, LDS_BYTES) != hipSuccess) { fprintf(stderr, "kernel_launch: hipFuncSetAttribute failed\n"); grid = -1; return; }
        if (hipOccupancyMaxActiveBlocksPerMultiprocessor(&per_cu, (const void*)fwd_kernel, NTHREADS, LDS_BYTES) != hipSuccess || per_cu < 1) { fprintf(stderr, "kernel_launch: occupancy query gives %d\n", per_cu); per_cu = 1; }
        (void)hipGetLastError();
        grid = cus * per_cu;
        fprintf(stderr, "kernel_launch: grid %d (cus %d x %d)\n", grid, cus, per_cu);
    }
    if (grid < 0) return;
    if (hipMemsetAsync((char*)d_ws + WS_BAR, 0, 16384, stream) != hipSuccess) { fprintf(stderr, "kernel_launch: memset failed\n"); return; }
    Params p{};
    for (int i = 0; i < 24; ++i) p.in[i] = (const float*)d_in[i];
    p.out = (float*)d_out; p.ws = (unsigned char*)d_ws;
#if MK_MULTI
    for (int ph = 0; ph < 15; ++ph) { p.ph_lo = ph; p.ph_hi = ph + 1; hipLaunchKernelGGL(fwd_kernel, dim3(grid), dim3(NTHREADS), LDS_BYTES, stream, p); }
#else
    p.ph_lo = 0; p.ph_hi = 14;
    void* args[] = {&p};
    hipError_t e = hipLaunchCooperativeKernel((const void*)fwd_kernel, dim3(grid), dim3(NTHREADS), args, LDS_BYTES, stream);
    if (e != hipSuccess) fprintf(stderr, "cooperative launch failed: %s (grid %d)\n", hipGetErrorString(e), grid);
#endif
}
```

```cpp
#include <hip/hip_runtime.h>
#include <hip/hip_cooperative_groups.h>
#include <cstdio>
#include <cstdint>
namespace cg = cooperative_groups;
namespace pg8 {
#define PG8_LAS __attribute__((address_space(3)))
typedef unsigned short bf16_t;
typedef short bf16x8 __attribute__((ext_vector_type(8)));
typedef float f32x4 __attribute__((ext_vector_type(4)));
typedef unsigned u32x4 __attribute__((ext_vector_type(4)));
constexpr int BM = 256, BK = 64, HALF = 128, HTB = HALF * BK * 2  , STAGE_BYTES = 8 * HTB, NXCD = 8, WGM = 8;

__host__ __device__ __forceinline__ int lds_byte(int r, int c) { const int st = (r >> 4) * 2 + (c >> 5), rr = r & 15, cc = c & 31, ob = rr * 64 + cc * 2; return st * 1024 + (ob ^ (((ob >> 9) & 1) << 5)); }
__host__ __device__ __forceinline__ void stage_rc(int b, int& R, int& C) { const int st = b / 1024, sb = b % 1024, swz = sb ^ (((sb >> 9) & 1) << 5); R = (st >> 1) * 16 + swz / 64; C = (st & 1) * 32 + (swz % 64) / 2; }
__host__ __device__ __forceinline__ int perm32(int rho) { const int n = rho >> 4, i = rho & 15; return 8 * (i >> 2) + 4 * n + (i & 3); }

struct Unit { int pm, pn, pk; };
struct Gemm { const bf16_t* A; const bf16_t* Bt; int M, N, K, ld; };

struct StaticOrder {
    int nM, nN, nwg, G, c;
    __host__ __device__ void init(int M, int N, int G_, int c_) { nM = M / BM; nN = N / BM; nwg = nM * nN; G = G_; c = c_; }
    __host__ __device__ bool next(int i, Unit& u) const {
        const long L = (long)i * G + c; if (L >= nwg) return false;
        int wgid = (int)L; { const int q = nwg / NXCD, r = nwg % NXCD, xcd = wgid % NXCD, off = wgid / NXCD; wgid = (xcd < r ? xcd * (q + 1) : r * (q + 1) + (xcd - r) * q) + off; }
        const int wgm = (nM % 9 == 0) ? 9 : WGM;
        const int nig = wgm * nN, gid = wgid / nig, fm = gid * wgm, gsz = (nM - fm) < wgm ? (nM - fm) : wgm;
        u.pm = fm + ((wgid % nig) % gsz); u.pn = (wgid % nig) / gsz; u.pk = 0; return true;
    }
    __device__ __forceinline__ void a_ready(const Unit&) const {}
    __device__ __forceinline__ void done(const Unit&) const {}
};

__device__ __forceinline__ unsigned cvt_pk_bf16(float lo, float hi) { unsigned r; asm volatile("v_cvt_pk_bf16_f32 %0, %1, %2" : "=v"(r) : "v"(lo), "v"(hi)); return r; }
typedef float f32x2 __attribute__((ext_vector_type(2)));
__device__ __forceinline__ f32x2 gelu_pk(f32x2 v) {
    const f32x2 av = __builtin_elementwise_abs(v), d = av * 0.2316418882f + 1.0f;
    f32x2 t; t.x = __builtin_amdgcn_rcpf(d.x); t.y = __builtin_amdgcn_rcpf(d.y);
    f32x2 q = t * 0.5307027145f + (-0.7265760135f); q = q * t + 0.7107068705f; q = q * t + (-0.142248368f); q = q * t + 0.127414796f; q = q * t;
    const f32x2 s = (v * v) * (-0.72134752044f);
    f32x2 e; e.x = __builtin_amdgcn_exp2f(s.x); e.y = __builtin_amdgcn_exp2f(s.y);
    const f32x2 m = v * (q * e), r = v - m;
    f32x2 o; o.x = v.x < 0.f ? m.x : r.x; o.y = v.y < 0.f ? m.y : r.y; return o;
}

template <int ACT  > struct EpiBf16 {
    static constexpr bool PERM = true, AFTER_DRAIN = false; static_assert(ACT == 0 || ACT == 1, "EpiBf16: ACT is 0 (none) or 1 (gelu_pk)");
    bf16_t* O; int ldc; const float* bias; int split_cols; size_t split_stride; float scale0;
    __device__ __forceinline__ void operator()(const f32x4 (&acc)[2][2][4][2], const Unit& u, int wr, int wc, int fr, int fq) const {
        const int row0 = u.pm * BM + wr * 64 + fr; int colt = u.pn * BM; bf16_t* base = O;
        float sc = 1.f; if (split_cols) { const int t = colt / split_cols; base += (size_t)t * split_stride; colt -= t * split_cols; if (t == 0) sc = scale0; }
        const int col0 = colt + wc * 32 + 8 * fq, bcol0 = u.pn * BM + wc * 32 + 8 * fq;
        f32x4 bv[2][2];
#pragma unroll
        for (int bj = 0; bj < 2; ++bj)
#pragma unroll
            for (int n = 0; n < 2; ++n) bv[bj][n] = bias ? *(const f32x4*)(bias + bcol0 + bj * HALF + 4 * n) : (f32x4){0.f, 0.f, 0.f, 0.f};
#pragma unroll
        for (int ai = 0; ai < 2; ++ai)
#pragma unroll
            for (int m = 0; m < 4; ++m) { bf16_t* rowp = base + (size_t)(row0 + ai * HALF + m * 16) * ldc + col0;
#pragma unroll
                for (int bj = 0; bj < 2; ++bj) { f32x4 v0 = acc[ai][bj][m][0] + bv[bj][0], v1 = acc[ai][bj][m][1] + bv[bj][1];
                    if (ACT == 1) { f32x2 a = gelu_pk((f32x2){v0[0], v0[1]}), b = gelu_pk((f32x2){v0[2], v0[3]}), c = gelu_pk((f32x2){v1[0], v1[1]}), d = gelu_pk((f32x2){v1[2], v1[3]});
                        v0 = (f32x4){a.x, a.y, b.x, b.y}; v1 = (f32x4){c.x, c.y, d.x, d.y}; }
                    v0 = v0 * sc; v1 = v1 * sc; u32x4 w; w.x = cvt_pk_bf16(v0[0], v0[1]); w.y = cvt_pk_bf16(v0[2], v0[3]); w.z = cvt_pk_bf16(v1[0], v1[1]); w.w = cvt_pk_bf16(v1[2], v1[3]);
                    *(u32x4*)(rowp + bj * HALF) = w; } }
    }
};
template <class Epi, class Sched, bool ALIGN_EPI = false, bool SP2 = false>
__device__ __forceinline__ void gemm_phase(PG8_LAS unsigned char* lds, const Gemm g, const Sched& S, const Epi& E) {
    const int tid = threadIdx.x, wid = __builtin_amdgcn_readfirstlane(tid >> 6), lane = tid & 63, wr = wid >> 2, wc = wid & 3, fr = lane & 15, fq = lane >> 4;
    const int K = g.K, nt = K / BK;
    unsigned voffA[2], voffB[2];
#pragma unroll
    for (int i = 0; i < 2; ++i) { int R, C; stage_rc(tid * 16 + i * 8192, R, C); const int Rb = Epi::PERM ? ((R & ~31) + perm32(R & 31)) : R;
        voffA[i] = (unsigned)(R * g.ld + C) * 2u; voffB[i] = (unsigned)(Rb * g.ld + C) * 2u; }
    const size_t kstep = (size_t)(BK * 2);
    const size_t hstep = (size_t)HALF * g.ld * 2;
    const size_t tstep = 2 * hstep;
    const unsigned ldsw = (unsigned)wid * 1024u;
    const int aoff = lds_byte(wr * 64 + fr, fq * 8), boff = lds_byte(wc * 32 + fr, fq * 8);
#define PG8_SA(b, h) (((b) * 2 + (h)) * HTB)
#define PG8_SB(b, h) ((4 + (b) * 2 + (h)) * HTB)
#define PG8_STAGE(bufoff, gbase, voff) do { _Pragma("unroll") for (int _i = 0; _i < 2; ++_i) \
        __builtin_amdgcn_global_load_lds((const unsigned*)((const char*)(gbase) + (voff)[_i]), (PG8_LAS unsigned*)(lds + (bufoff) + ldsw + _i * 8192), 16, 0, 0); } while (0)
#define PG8_LDA(dst, b, h) do { _Pragma("unroll") for (int m = 0; m < 4; ++m) _Pragma("unroll") for (int k = 0; k < 2; ++k) dst[m][k] = *(const PG8_LAS bf16x8*)(lds + PG8_SA(b, h) + aoff + m * 2048 + k * 1024); } while (0)
#define PG8_LDB(dst, b, h) do { _Pragma("unroll") for (int n = 0; n < 2; ++n) _Pragma("unroll") for (int k = 0; k < 2; ++k) dst[n][k] = *(const PG8_LAS bf16x8*)(lds + PG8_SB(b, h) + boff + n * 2048 + k * 1024); } while (0)
#define PG8_MMA(ai, bj, At, Bt) do { __builtin_amdgcn_s_setprio(1); _Pragma("unroll") for (int m = 0; m < 4; ++m) _Pragma("unroll") for (int n = 0; n < 2; ++n) _Pragma("unroll") for (int k = 0; k < 2; ++k) \
        acc[ai][bj][m][n] = __builtin_amdgcn_mfma_f32_16x16x32_bf16(Bt[n][k], At[m][k], acc[ai][bj][m][n], 0, 0, 0); __builtin_amdgcn_s_setprio(0); } while (0)
#define PG8_WAIT_V(n) asm volatile("s_waitcnt vmcnt(" #n ")" ::: "memory")
#define PG8_WAIT_L(n) asm volatile("s_waitcnt lgkmcnt(" #n ")" ::: "memory")
#define PG8_BAR __builtin_amdgcn_s_barrier()
#define PG8_SCHED __builtin_amdgcn_sched_barrier(0)
    Unit cur, nxt; int ui = 0;
    if (!S.next(0, cur)) return;
    f32x4 acc[2][2][4][2];
#pragma unroll
    for (int a = 0; a < 2; ++a)
#pragma unroll
        for (int b = 0; b < 2; ++b)
#pragma unroll
            for (int m = 0; m < 4; ++m)
#pragma unroll
                for (int n = 0; n < 2; ++n) acc[a][b][m][n] = (f32x4){0.f, 0.f, 0.f, 0.f};
    bf16x8 At[4][2], B0[2][2], B1[2][2];
    const char* cA = (const char*)g.A + (size_t)cur.pm * tstep + (size_t)cur.pk * K * 2; const char* cB = (const char*)g.Bt + (size_t)cur.pn * tstep + (size_t)cur.pk * K * 2;
    S.a_ready(cur);
    if constexpr (SP2) {
        PG8_STAGE(PG8_SB(0, 0), cB, voffB); PG8_STAGE(PG8_SB(0, 1), cB + hstep, voffB); PG8_STAGE(PG8_SA(0, 0), cA, voffA); PG8_STAGE(PG8_SA(0, 1), cA + hstep, voffA);
        if (wr == 1) PG8_BAR;
        PG8_WAIT_V(2); PG8_BAR;
        PG8_STAGE(PG8_SB(1, 0), cB + kstep, voffB); PG8_STAGE(PG8_SA(1, 0), cA + kstep, voffA); PG8_STAGE(PG8_SB(1, 1), cB + hstep + kstep, voffB);
        PG8_WAIT_V(6); PG8_BAR;
    } else {
        PG8_STAGE(PG8_SB(0, 0), cB, voffB); PG8_STAGE(PG8_SA(0, 0), cA, voffA); PG8_STAGE(PG8_SB(0, 1), cB + hstep, voffB); PG8_STAGE(PG8_SA(0, 1), cA + hstep, voffA);
        if (wr == 1) PG8_BAR;
        PG8_WAIT_V(4); PG8_BAR;
        PG8_STAGE(PG8_SB(1, 0), cB + kstep, voffB); PG8_STAGE(PG8_SA(1, 0), cA + kstep, voffA); PG8_STAGE(PG8_SB(1, 1), cB + hstep + kstep, voffB);
        PG8_WAIT_V(6); PG8_BAR;
    }
    for (;;) {
        const bool has_next = S.next(ui + 1, nxt);
        const char* nA = has_next ? (const char*)g.A + (size_t)nxt.pm * tstep + (size_t)nxt.pk * K * 2 : cA; const char* nB = has_next ? (const char*)g.Bt + (size_t)nxt.pn * tstep + (size_t)nxt.pk * K * 2 : cB;
        for (int t = 0; t < nt; t += 2) {
            const bool last = (t == nt - 2);
            const char* a1 = cA + (size_t)(t + 1) * kstep;
            const char* a2 = last ? nA : cA + (size_t)(t + 2) * kstep; const char* b2 = last ? nB : cB + (size_t)(t + 2) * kstep;
            const char* a3 = a2 + kstep; const char* b3 = b2 + kstep;
            if (last && has_next) S.a_ready(nxt);
            if constexpr (SP2) {
            PG8_LDB(B0, 0, 0); PG8_LDB(B1, 0, 1); PG8_SCHED; PG8_LDA(At, 0, 0); PG8_STAGE(PG8_SA(1, 1), a1 + hstep, voffA);
            PG8_WAIT_V(8); PG8_WAIT_L(0); PG8_BAR; PG8_MMA(0, 0, At, B0); PG8_MMA(0, 1, At, B1); PG8_BAR; PG8_SCHED;
            PG8_LDA(At, 0, 1); PG8_STAGE(PG8_SB(0, 0), b2, voffB); PG8_STAGE(PG8_SB(0, 1), b2 + hstep, voffB); PG8_STAGE(PG8_SA(0, 0), a2, voffA);
            PG8_WAIT_V(8); PG8_WAIT_L(0); PG8_BAR; PG8_MMA(1, 0, At, B0); PG8_MMA(1, 1, At, B1); PG8_BAR; PG8_SCHED;
            PG8_LDB(B0, 1, 0); PG8_LDB(B1, 1, 1); PG8_SCHED; PG8_LDA(At, 1, 0); PG8_STAGE(PG8_SA(0, 1), a2 + hstep, voffA);
            PG8_WAIT_V(8); PG8_WAIT_L(0); PG8_BAR; PG8_MMA(0, 0, At, B0); PG8_MMA(0, 1, At, B1); PG8_BAR; PG8_SCHED;
            PG8_LDA(At, 1, 1); PG8_STAGE(PG8_SB(1, 0), b3, voffB); PG8_STAGE(PG8_SB(1, 1), b3 + hstep, voffB); PG8_STAGE(PG8_SA(1, 0), a3, voffA);
            PG8_WAIT_V(8); PG8_WAIT_L(0); PG8_BAR; PG8_MMA(1, 0, At, B0); PG8_MMA(1, 1, At, B1); PG8_BAR; PG8_SCHED;
            } else {
            PG8_LDB(B0, 0, 0); PG8_SCHED; PG8_LDA(At, 0, 0); PG8_STAGE(PG8_SA(1, 1), a1 + hstep, voffA);
            PG8_WAIT_L(8); PG8_BAR; PG8_WAIT_L(0); PG8_MMA(0, 0, At, B0); PG8_BAR; PG8_SCHED;
            PG8_LDB(B1, 0, 1); PG8_STAGE(PG8_SB(0, 0), b2, voffB);
            PG8_BAR; PG8_WAIT_L(0); PG8_MMA(0, 1, At, B1); PG8_BAR;
            PG8_LDA(At, 0, 1); PG8_STAGE(PG8_SA(0, 0), a2, voffA);
            PG8_BAR; PG8_WAIT_L(0); PG8_MMA(1, 0, At, B0); PG8_BAR; PG8_SCHED;
            PG8_STAGE(PG8_SB(0, 1), b2 + hstep, voffB);
            PG8_WAIT_V(6); PG8_BAR; PG8_MMA(1, 1, At, B1); PG8_BAR;
            PG8_LDB(B0, 1, 0); PG8_SCHED; PG8_LDA(At, 1, 0); PG8_STAGE(PG8_SA(0, 1), a2 + hstep, voffA);
            PG8_WAIT_L(8); PG8_BAR; PG8_WAIT_L(0); PG8_MMA(0, 0, At, B0); PG8_BAR; PG8_SCHED;
            PG8_LDB(B1, 1, 1); PG8_STAGE(PG8_SB(1, 0), b3, voffB);
            PG8_BAR; PG8_WAIT_L(0); PG8_MMA(0, 1, At, B1); PG8_BAR;
            PG8_LDA(At, 1, 1); PG8_STAGE(PG8_SA(1, 0), a3, voffA);
            PG8_BAR; PG8_WAIT_L(0); PG8_MMA(1, 0, At, B0); PG8_BAR; PG8_SCHED;
            PG8_STAGE(PG8_SB(1, 1), b3 + hstep, voffB);
            PG8_WAIT_V(6); PG8_BAR; PG8_MMA(1, 1, At, B1); PG8_BAR;
            }
        }
        if constexpr (ALIGN_EPI) { if (wr == 0) PG8_BAR; }
        if constexpr (!Epi::AFTER_DRAIN) { E(acc, cur, wr, wc, fr, fq); S.done(cur); }
        if (!has_next) break;
#pragma unroll
        for (int a = 0; a < 2; ++a)
#pragma unroll
            for (int b = 0; b < 2; ++b)
#pragma unroll
                for (int m = 0; m < 4; ++m)
#pragma unroll
                    for (int n = 0; n < 2; ++n) acc[a][b][m][n] = (f32x4){0.f, 0.f, 0.f, 0.f};
        cur = nxt; cA = nA; cB = nB; ++ui;
        if constexpr (ALIGN_EPI) { if (wr == 1) PG8_BAR; }
    }
    PG8_WAIT_V(0);
    if constexpr (!ALIGN_EPI) { if (wr == 0) PG8_BAR; }
    PG8_BAR;
    if constexpr (Epi::AFTER_DRAIN) { E.fused(acc, cur, wr, wc, fr, fq, lds, wid, lane); S.done(cur); }
#undef PG8_SA
#undef PG8_SB
#undef PG8_STAGE
#undef PG8_LDA
#undef PG8_LDB
#undef PG8_MMA
#undef PG8_WAIT_V
#undef PG8_WAIT_L
#undef PG8_BAR
#undef PG8_SCHED
}
}

namespace mk {
#define LAS __attribute__((address_space(3)))
typedef unsigned short bf16;
typedef short bf16x8 __attribute__((ext_vector_type(8)));
typedef float f32x4 __attribute__((ext_vector_type(4)));
typedef float f32x16 __attribute__((ext_vector_type(16)));
typedef unsigned u32x4 __attribute__((ext_vector_type(4)));
typedef unsigned u32x2 __attribute__((ext_vector_type(2)));

constexpr int DM = 1024, MLAT = 16384, MCTX = 2048, MALL = 18432, NIN = 2048, FF = 2816, NGU = 5632, SEQ = 2048, CTXL = 256;
constexpr float EPS = 1e-6f, LOG2E = 1.4426950408889634f;
constexpr int NTHREADS = 512, NWAVES = 8;
constexpr int LDS_BYTES = 143360;
constexpr int LDS_ROPE = 131072 + 1024;

constexpr size_t WS_WIN = 0;
constexpr size_t WS_WOUT = WS_WIN + 2ull * NIN * DM * 2;
constexpr size_t WS_WGU = WS_WOUT + 2ull * DM * DM * 2;
constexpr size_t WS_WD = WS_WGU + 2ull * NGU * DM * 2;
constexpr size_t WS_MOD = WS_WD + 2ull * DM * FF * 2;
constexpr size_t WS_ROPE = WS_MOD + 2ull * 9 * 6144 * 4;
constexpr size_t WS_WSBF = WS_ROPE + 8192;
constexpr size_t WS_WPT = WS_WSBF + 2ull * 4 * 128 * 128 * 2;
constexpr size_t WS_XC = WS_WPT + 2ull * 4 * 64 * 64 * 2;
constexpr size_t WS_BAR = WS_XC + (size_t)MCTX * DM * 4;
constexpr size_t WS_GS = WS_BAR + 16384;
constexpr size_t WS_BIAS1 = WS_GS + 2ull * 2 * 9 * 1024 * 4;
constexpr size_t WS_BIAS2 = WS_BIAS1 + 2ull * 9 * NIN * 4;
constexpr size_t WS_SS = WS_BIAS2 + 2ull * 9 * NGU * 4;
constexpr size_t WS_H = WS_SS + 4ull * MALL * 4;
constexpr size_t WS_P = WS_H + (size_t)MALL * DM * 2;
constexpr size_t WS_MIX = WS_P + (size_t)MALL * NIN * 2;
constexpr size_t WS_HID = WS_P;
constexpr size_t WS_PART2 = WS_P;
constexpr size_t WS_PART4 = WS_HID + (size_t)MALL * FF * 2;
constexpr size_t WS_END = WS_PART4 + 8ull * MCTX * DM * 4;
static_assert((size_t)MALL * FF * 2 <= (size_t)MALL * NIN * 2 + (size_t)MALL * DM * 2, "HID overlay");

struct Params { const float* in[24]; float* out; unsigned char* ws; int ph_lo, ph_hi; };
typedef const __attribute__((address_space(4))) Params* KArgPtr;
struct KIn { KArgPtr k; __device__ __forceinline__ const float* operator[](int i) const { return k->in[i]; } };
struct KP { KIn in; float* out; unsigned char* ws; };
__device__ __forceinline__ KP make_kp() { KArgPtr k = (KArgPtr)__builtin_amdgcn_kernarg_segment_ptr(); asm volatile("" : "+s"(k));
    KP p; p.in.k = k; p.out = p.in.k->out; p.ws = p.in.k->ws; return p; }
enum { I_X = 0, I_C, I_CTX, I_CCTX, I_WMOD, I_BMOD, I_GMIX, I_GFFN, I_WIN, I_WOUT, I_AQG, I_AKG, I_ASINK, I_BVG, I_BWS, I_BBS, I_CWP, I_CSC, I_DQG, I_DKG, I_RPB, I_WG, I_WU, I_WDN };

__device__ __forceinline__ unsigned f2bf(float f) { unsigned u = __float_as_uint(f); return (u + 0x7fffu + ((u >> 16) & 1u)) >> 16; }
typedef __bf16 bf16x2_t __attribute__((ext_vector_type(2)));
__device__ __forceinline__ unsigned pk2(float lo, float hi) { bf16x2_t v; v.x = (__bf16)lo; v.y = (__bf16)hi; return __builtin_bit_cast(unsigned, v); }
__device__ __forceinline__ float bflo(unsigned w) { return __uint_as_float(w << 16); }
__device__ __forceinline__ float bfhi(unsigned w) { return __uint_as_float(w & 0xffff0000u); }
__device__ __forceinline__ float wave_sum(float v) {
#pragma unroll
    for (int o = 1; o < 64; o <<= 1) v += __shfl_xor(v, o);
    return v;
}
__device__ __forceinline__ float gelu_tanh(float x) {
    const float u = 0.7978845608028654f * (x + 0.044715f * x * x * x);
    const float t = __builtin_amdgcn_exp2f(u * (2.0f * LOG2E));
    const float th = 1.0f - 2.0f * __builtin_amdgcn_rcpf(t + 1.0f);
    return 0.5f * x * (1.0f + th);
}
__device__ __forceinline__ float silu_f(float x) { return x / (1.0f + __expf(-x)); }
__device__ __forceinline__ f32x16 mfma32(bf16x8 a, bf16x8 b, f32x16 c) { return __builtin_amdgcn_mfma_f32_32x32x16_bf16(a, b, c, 0, 0, 0); }
__device__ __forceinline__ bf16x8 as_bf16x8(u32x4 v) { return __builtin_bit_cast(bf16x8, v); }

template <bool WITH_H>
struct EpiResGate {
    static constexpr bool PERM = true, AFTER_DRAIN = false;
    const float* src; float* dst; const float* gate; bf16* H; float* ss; const float* gs;
    __device__ __forceinline__ void operator()(const pg8::f32x4 (&acc)[2][2][4][2], const pg8::Unit& u, int wr, int wc, int fr, int fq) const {
        const int rbase = u.pm * 256 + wr * 64 + fr;
        const int bb = u.pm >> 3;
        const float* gr = gate + bb * 6144;
        const int col0 = u.pn * 256 + wc * 32 + 8 * fq;
        pg8::f32x4 gv[2][2], sv[2][2];
#pragma unroll
        for (int bj = 0; bj < 2; ++bj)
#pragma unroll
            for (int n = 0; n < 2; ++n) { gv[bj][n] = *(const pg8::f32x4*)(gr + col0 + bj * 128 + n * 4); if (WITH_H) sv[bj][n] = *(const pg8::f32x4*)(gs + bb * 1024 + col0 + bj * 128 + n * 4); }
#pragma unroll
        for (int am = 0; am < 4; ++am) { const int ai = am >> 1, m0 = 2 * (am & 1);
            pg8::f32x4 xpre[4][2][2];
#pragma unroll
            for (int m = m0; m < m0 + 2; ++m) { const size_t off = (size_t)(rbase + ai * 128 + m * 16) * DM + col0;
#pragma unroll
                for (int bj = 0; bj < 2; ++bj)
#pragma unroll
                    for (int n = 0; n < 2; ++n) xpre[m][bj][n] = *(const pg8::f32x4*)(src + off + bj * 128 + n * 4); }
#pragma unroll
            for (int m = m0; m < m0 + 2; ++m) { const int row = rbase + ai * 128 + m * 16; const size_t off = (size_t)row * DM + col0; float q = 0.f;
#pragma unroll
                for (int bj = 0; bj < 2; ++bj) { pg8::f32x4 xn[2];
#pragma unroll
                    for (int n = 0; n < 2; ++n) { const pg8::f32x4 xv = xpre[m][bj][n];
                        xn[n] = xv + gv[bj][n] * acc[ai][bj][m][n];
                        *(pg8::f32x4*)(dst + off + bj * 128 + n * 4) = xn[n];
                        if (WITH_H) q += (xn[n][0] * xn[n][0] + xn[n][1] * xn[n][1]) + (xn[n][2] * xn[n][2] + xn[n][3] * xn[n][3]); }
                    if (WITH_H) { const pg8::f32x4 h0 = xn[0] * sv[bj][0], h1 = xn[1] * sv[bj][1];
                        u32x4 w; w.x = pk2(h0[0], h0[1]); w.y = pk2(h0[2], h0[3]); w.z = pk2(h1[0], h1[1]); w.w = pk2(h1[2], h1[3]); *(u32x4*)(H + off + bj * 128) = w; } }
                if (WITH_H) { q += __shfl_xor(q, 16); q += __shfl_xor(q, 32); if (fq == 0) __hip_atomic_fetch_add(ss + row, q, __ATOMIC_RELAXED, __HIP_MEMORY_SCOPE_AGENT); } } }
    }
};
struct EpiPartial {
    static constexpr bool PERM = false, AFTER_DRAIN = false;
    float* dst; int slot0;
    __device__ __forceinline__ void operator()(const pg8::f32x4 (&acc)[2][2][4][2], const pg8::Unit& u, int wr, int wc, int fr, int fq) const {
        const int rbase = u.pm * 256 + wr * 64 + fr, col0 = u.pn * 256 + wc * 32 + 4 * fq;
        float* base = dst + (size_t)(slot0 + u.pk) * MCTX * DM;
#pragma unroll
        for (int ai = 0; ai < 2; ++ai)
#pragma unroll
            for (int m = 0; m < 4; ++m) { float* d = base + (size_t)(rbase + ai * 128 + m * 16) * DM + col0;
#pragma unroll
                for (int bj = 0; bj < 2; ++bj)
#pragma unroll
                    for (int n = 0; n < 2; ++n) *(pg8::f32x4*)(d + bj * 128 + n * 16) = acc[ai][bj][m][n]; }
    }
};
struct SplitKOrder {
    int nsplit, nN, nunits, G, c;
    __device__ void init(int nM, int nN_, int nsplit_, int G_, int c_, int rot) { nsplit = nsplit_; nN = nN_; nunits = nM * nN_ * nsplit_; G = G_; c = (c_ + G_ - rot) % G_; }
    __device__ bool next(int i, pg8::Unit& u) const { const int L = i * G + c; if (L >= nunits) return false; const int tile = L / nsplit; u.pk = L - tile * nsplit; u.pm = tile / nN; u.pn = tile - u.pm * nN; return true; }
    __device__ __forceinline__ void a_ready(const pg8::Unit&) const {}
    __device__ __forceinline__ void done(const pg8::Unit&) const {}
};
__device__ __forceinline__ float row_rstd(const float* ss, int row) { return 1.0f / sqrtf(ss[row] * (1.0f / DM) + EPS); }
struct EpiG1 {
    static constexpr bool PERM = true, AFTER_DRAIN = false;
    bf16* O; const float* ss; const float* bias; const float* aqg; const float* akg; const float* dqg; const float* dkg; const LAS float* rope;
    __device__ __forceinline__ void operator()(const pg8::f32x4 (&acc)[2][2][4][2], const pg8::Unit& u, int wr, int wc, int fr, int fq) const {
        const bool lat = u.pm < (MLAT / 256);
        const int bb = lat ? (u.pm >> 3) : 8;
        const int row0 = u.pm * 256 + wr * 64 + fr;
        const float* br = bias + bb * NIN + u.pn * 256 + wc * 32 + 8 * fq;
        const int colL = u.pn * 256 + 64 * wc + 8 * fq;
        const float* gain = nullptr; float qs = 1.0f; int mode = 0;
        if (u.pn == 0) { gain = aqg; qs = 0.125f * LOG2E; mode = 2; }
        else if (u.pn == 1 && wc < 2) { gain = akg; mode = 2; }
        else if (u.pn == 5) { gain = dqg; qs = 0.125f * LOG2E; mode = 1; }
        else if (u.pn == 6) { gain = dkg; mode = 1; }
        if (mode == 2 && !lat) mode = 1;
        pg8::f32x4 bv[2][2], gn[2][2];
#pragma unroll
        for (int bj = 0; bj < 2; ++bj)
#pragma unroll
            for (int n = 0; n < 2; ++n) { bv[bj][n] = *(const pg8::f32x4*)(br + bj * 128 + 4 * n); gn[bj][n] = mode ? *(const pg8::f32x4*)(gain + 32 * bj + 8 * fq + 4 * n) : (pg8::f32x4){1.f, 1.f, 1.f, 1.f}; }
        const float sgn = fq < 2 ? -1.0f : 1.0f;
        float rsv[2][4];
#pragma unroll
        for (int ai = 0; ai < 2; ++ai)
#pragma unroll
            for (int m = 0; m < 4; ++m) rsv[ai][m] = ss[row0 + ai * 128 + m * 16];
#pragma unroll
        for (int ai = 0; ai < 2; ++ai)
#pragma unroll
            for (int m = 0; m < 4; ++m) { const int row = row0 + ai * 128 + m * 16; const float rs = __builtin_amdgcn_rsqf(rsv[ai][m] * (1.0f / DM) + EPS);
                pg8::f32x4 v[2][2];
#pragma unroll
                for (int bj = 0; bj < 2; ++bj)
#pragma unroll
                    for (int n = 0; n < 2; ++n) v[bj][n] = acc[ai][bj][m][n] * rs + bv[bj][n];
                if (mode) {
                    float q = 0.f;
#pragma unroll
                    for (int bj = 0; bj < 2; ++bj)
#pragma unroll
                        for (int n = 0; n < 2; ++n) q += (v[bj][n][0] * v[bj][n][0] + v[bj][n][1] * v[bj][n][1]) + (v[bj][n][2] * v[bj][n][2] + v[bj][n][3] * v[bj][n][3]);
                    q += __shfl_xor(q, 16); q += __shfl_xor(q, 32);
                    const float hr = __builtin_amdgcn_rsqf(q * (1.0f / 64.0f) + EPS) * qs;
#pragma unroll
                    for (int bj = 0; bj < 2; ++bj)
#pragma unroll
                        for (int n = 0; n < 2; ++n) v[bj][n] = v[bj][n] * hr * gn[bj][n];
                    if (mode == 2) {
                        const int pos = row & (SEQ - 1);
#pragma unroll
                        for (int bj = 0; bj < 2; ++bj) { const int pp = bj ? (pos & 63) : (pos >> 6);
#pragma unroll
                            for (int n = 0; n < 2; ++n) { const LAS float* tb = rope + (pp * 16 + 8 * (fq & 1) + 4 * n) * 2;
                                const pg8::f32x4 cs0 = *(const LAS pg8::f32x4*)(tb), cs1 = *(const LAS pg8::f32x4*)(tb + 4);
                                const float co[4] = {cs0[0], cs0[2], cs1[0], cs1[2]}, sn[4] = {cs0[1], cs0[3], cs1[1], cs1[3]};
#pragma unroll
                                for (int j = 0; j < 4; ++j) { const float own = v[bj][n][j]; const float oth = __shfl_xor(own, 32); v[bj][n][j] = own * co[j] + sgn * oth * sn[j]; } } }
                    }
                }
#pragma unroll
                for (int bj = 0; bj < 2; ++bj) { u32x4 w; w.x = pk2(v[bj][0][0], v[bj][0][1]); w.y = pk2(v[bj][0][2], v[bj][0][3]); w.z = pk2(v[bj][1][0], v[bj][1][1]); w.w = pk2(v[bj][1][2], v[bj][1][3]);
                    *(u32x4*)(O + (size_t)row * NIN + colL + 32 * bj) = w; } }
    }
};
struct EpiSwiglu {
    static constexpr bool PERM = true, AFTER_DRAIN = false;
    bf16* O; const float* ss; const float* bias;
    __device__ __forceinline__ void operator()(const pg8::f32x4 (&acc)[2][2][4][2], const pg8::Unit& u, int wr, int wc, int fr, int fq) const {
        const int bb = u.pm >= (MLAT / 256) ? 8 : (u.pm >> 3);
        const int row0 = u.pm * 256 + wr * 64 + fr, col0 = u.pn * 128 + wc * 32 + 8 * fq;
        const float* br = bias + bb * NGU + u.pn * 256 + wc * 32 + 8 * fq;
        pg8::f32x4 bg[2], bu[2];
#pragma unroll
        for (int n = 0; n < 2; ++n) { bg[n] = *(const pg8::f32x4*)(br + 4 * n); bu[n] = *(const pg8::f32x4*)(br + 128 + 4 * n); }
        float rsv[2][4];
#pragma unroll
        for (int ai = 0; ai < 2; ++ai)
#pragma unroll
            for (int m = 0; m < 4; ++m) rsv[ai][m] = ss[row0 + ai * 128 + m * 16];
#pragma unroll
        for (int ai = 0; ai < 2; ++ai)
#pragma unroll
            for (int m = 0; m < 4; ++m) { const int row = row0 + ai * 128 + m * 16; const float rs = __builtin_amdgcn_rsqf(rsv[ai][m] * (1.0f / DM) + EPS);
                float hv[8];
#pragma unroll
                for (int n = 0; n < 2; ++n)
#pragma unroll
                    for (int j = 0; j < 4; ++j) { const float g = acc[ai][0][m][n][j] * rs + bg[n][j], up = acc[ai][1][m][n][j] * rs + bu[n][j]; hv[4 * n + j] = g * __builtin_amdgcn_rcpf(1.0f + __builtin_amdgcn_exp2f(-g * LOG2E)) * up; }
                u32x4 w; w.x = pk2(hv[0], hv[1]); w.y = pk2(hv[2], hv[3]); w.z = pk2(hv[4], hv[5]); w.w = pk2(hv[6], hv[7]);
                *(u32x4*)(O + (size_t)row * FF + col0) = w; }
    }
};

typedef unsigned gu32;
#define XB_TMO      128
#define XB_XCNT(j)  (256  + 64 * (j))
#define XB_XSUB(j)  (1280 + 64 * (j))
#define XB_XGEN(j)  (2304 + 64 * (j))
#define XB_TOP      3328
#define XB_TOPGEN   3392
#define XCD_BAR_WORDS 3456
#define XB_SPIN_CAP (1u << 18)

__device__ __forceinline__ unsigned xb_ld(unsigned* p)              { return __hip_atomic_load(p, __ATOMIC_RELAXED, __HIP_MEMORY_SCOPE_AGENT); }
__device__ __forceinline__ unsigned xb_add(unsigned* p, unsigned v) { return __hip_atomic_fetch_add(p, v, __ATOMIC_RELAXED, __HIP_MEMORY_SCOPE_AGENT); }
__device__ __forceinline__ unsigned xb_xcc_id() { return (unsigned)__builtin_amdgcn_s_getreg((3 << 11) | 20) & 0xFu; }
#define XB_SPIN(cond, bar) do { unsigned _sp = 0; while (cond) { __builtin_amdgcn_s_sleep(1); \
    if ((++_sp & 255u) == 0u) { if (xb_ld(&(bar)[XB_TMO])) break; if (_sp > XB_SPIN_CAP) { atomicAdd(&(bar)[XB_TMO], 1u); break; } } } } while (0)

struct XcdBarrier {
    unsigned* bar; unsigned x;
    volatile LAS unsigned* st;
};

__device__ __forceinline__ XcdBarrier xcd_barrier_post(unsigned* bar, volatile LAS unsigned* st) {
    XcdBarrier b; b.bar = bar; b.x = xb_xcc_id(); b.st = st;
    if (threadIdx.x == 0) (void)xb_add(&bar[XB_XCNT(b.x)], 1u);
    return b;
}
__device__ __forceinline__ void xcd_barrier_complete(unsigned* bar, unsigned x, unsigned& nloc, unsigned& nx) {
    const unsigned G = gridDim.x * gridDim.y * gridDim.z;
    unsigned sum, cnt, mine, sp = 0u;
    for (;;) {
        sum = 0u; cnt = 0u; mine = 0u;
#pragma unroll
        for (unsigned j = 0; j < 16; ++j) { const unsigned c = xb_ld(&bar[XB_XCNT(j)]); sum += c; cnt += (c > 0u) ? 1u : 0u; mine = (j == x) ? c : mine; }
        if (sum == G) break;
        __builtin_amdgcn_s_sleep(1);
        if ((++sp & 255u) == 0u) { if (xb_ld(&bar[XB_TMO])) break; if (sp > XB_SPIN_CAP) { atomicAdd(&bar[XB_TMO], 1u); break; } }
    }
    nloc = mine > 0u ? mine : 1u; nx = cnt > 0u ? cnt : 1u;
}

__device__ __forceinline__ void xcd_barrier(const XcdBarrier& b) {
    asm volatile("s_waitcnt vmcnt(0)" ::: "memory");
    __syncthreads();
    if (threadIdx.x == 0) {
        unsigned* bar = b.bar;
        __builtin_amdgcn_s_waitcnt(0);
        unsigned nloc = b.st[0], nx = b.st[1];
        if (nloc == 0u) { xcd_barrier_complete(bar, b.x, nloc, nx); b.st[0] = nloc; b.st[1] = nx; }
        const unsigned old = xb_add(&bar[XB_XSUB(b.x)], 1u);
        const unsigned gen = old / nloc;
        if (old + 1u == (gen + 1u) * nloc) {
            __builtin_amdgcn_fence(__ATOMIC_RELEASE, "agent");
            asm volatile("s_waitcnt vmcnt(0)" ::: "memory");
            const unsigned og = xb_add(&bar[XB_TOP], 1u);
            const unsigned tg = og / nx;
            if (og + 1u == (tg + 1u) * nx) xb_add(&bar[XB_TOPGEN], 1u);
            else XB_SPIN(xb_ld(&bar[XB_TOPGEN]) == tg, bar);
            __builtin_amdgcn_fence(__ATOMIC_ACQUIRE, "agent");
            xb_add(&bar[XB_XGEN(b.x)], 1u);
            asm volatile("s_waitcnt vmcnt(0)" ::: "memory");
        } else {
            XB_SPIN(xb_ld(&bar[XB_XGEN(b.x)]) == gen, bar);
            __builtin_amdgcn_fence(__ATOMIC_ACQUIRE, "agent");
            asm volatile("s_waitcnt vmcnt(0)" ::: "memory");
        }
    }
    __syncthreads();
}
__device__ __forceinline__ void transpose_item(const float* W, int K, int N, bf16* WT, int k0, int n0, int drow, float* scr, int lane) {
    float tv[32];
#pragma unroll
    for (int i = 0; i < 32; ++i) tv[i] = W[(size_t)(k0 + 2 * i + (lane >> 5)) * N + n0 + (lane & 31)];
#pragma unroll
    for (int i = 0; i < 32; ++i) scr[(2 * i + (lane >> 5)) * 33 + (lane & 31)] = tv[i];
    asm volatile("s_waitcnt lgkmcnt(0)" ::: "memory");
    const int c = lane & 7;
#pragma unroll
    for (int j = 0; j < 4; ++j) { const int n = (lane >> 3) + 8 * j; const float* s = scr + (8 * c) * 33 + n;
        u32x4 o; o.x = pk2(s[0 * 33], s[1 * 33]); o.y = pk2(s[2 * 33], s[3 * 33]); o.z = pk2(s[4 * 33], s[5 * 33]); o.w = pk2(s[6 * 33], s[7 * 33]);
        *(u32x4*)(WT + (size_t)(drow + n) * K + k0 + 8 * c) = o; }
    asm volatile("s_waitcnt lgkmcnt(0)" ::: "memory");
}

__device__ __forceinline__ void phase_transposes(const KP& p, unsigned char* lds, int part, int first_blk, int nblk) {
    const int lane = threadIdx.x & 63, wave = threadIdx.x >> 6;
    unsigned char* ws = p.ws;
    float* scr = (float*)(lds + wave * 16384);
    if ((int)blockIdx.x < first_blk) return;
    const int gw = ((int)blockIdx.x - first_blk) * NWAVES + wave, NGW = nblk * NWAVES;
    if (part == 0) {
        for (int it = gw; it < 2 * 1024; it += NGW) { const int l = it >> 10, r = it & 1023; const int kb = r >> 6, nb = r & 63;
            transpose_item(p.in[I_WIN] + (size_t)l * DM * NIN, DM, NIN, (bf16*)(ws + WS_WIN) + (size_t)l * NIN * DM, 64 * kb, 32 * nb, 256 * (nb >> 3) + 128 * (nb & 1) + 32 * ((nb >> 1) & 3), scr, lane); }
        return;
    }
    for (int it = gw; it < 2 * 4736; it += NGW) {
        const int l = it / 4736; int r = it % 4736;
        if (r < 512) { const int kb = r >> 5, nb = r & 31; transpose_item(p.in[I_WOUT] + (size_t)l * DM * DM, DM, DM, (bf16*)(ws + WS_WOUT) + (size_t)l * DM * DM, 64 * kb, 32 * nb, 32 * nb, scr, lane); continue; } r -= 512;
        if (r < 1408) { const int kb = r / 88, nb = r % 88, n0 = 32 * nb; transpose_item(p.in[I_WG] + (size_t)l * DM * FF, DM, FF, (bf16*)(ws + WS_WGU) + (size_t)l * NGU * DM, 64 * kb, n0, 256 * (n0 >> 7) + (n0 & 127), scr, lane); continue; } r -= 1408;
        if (r < 1408) { const int kb = r / 88, nb = r % 88, n0 = 32 * nb; transpose_item(p.in[I_WU] + (size_t)l * DM * FF, DM, FF, (bf16*)(ws + WS_WGU) + (size_t)l * NGU * DM, 64 * kb, n0, 256 * (n0 >> 7) + 128 + (n0 & 127), scr, lane); continue; } r -= 1408;
        { const int kb = r >> 5, nb = r & 31; transpose_item(p.in[I_WDN] + (size_t)l * FF * DM, FF, DM, (bf16*)(ws + WS_WD) + (size_t)l * DM * FF, 64 * kb, 32 * nb, 32 * nb, scr, lane); }
    }
}
__device__ __forceinline__ void phase_prologue(const KP& p, unsigned char* lds) {
    const int tid = threadIdx.x, lane = tid & 63, wave = tid >> 6;
    unsigned char* ws = p.ws;
    if (blockIdx.x < 192) {
        const int l = blockIdx.x / 96, c0 = 64 * (blockIdx.x % 96);
        float* act = (float*)lds;
        for (int i = tid; i < 9 * 1024; i += NTHREADS) { const int bb = i >> 10, k = i & 1023; const float v = bb < 8 ? p.in[I_C][bb * 1024 + k] : p.in[I_CCTX][k]; act[i] = v / (1.0f + expf(-v)); }
        __syncthreads();
        const float* w = p.in[I_WMOD] + (size_t)l * 1024 * 6144 + c0 + lane;
        float acc[9];
#pragma unroll
        for (int b = 0; b < 9; ++b) acc[b] = 0.f;
        const int kbeg = wave * 128;
#pragma unroll 32
        for (int k = kbeg; k < kbeg + 128; ++k) { const float wv = w[(size_t)k * 6144];
#pragma unroll
            for (int b = 0; b < 9; ++b) acc[b] += act[b * 1024 + k] * wv; }
        float* red = (float*)(lds + 40960);
#pragma unroll
        for (int b = 0; b < 9; ++b) red[(wave * 9 + b) * 64 + lane] = acc[b];
        __syncthreads();
        float* mod = (float*)(ws + WS_MOD);
        for (int i = tid; i < 576; i += NTHREADS) { const int b = i >> 6, cc = i & 63; float s = p.in[I_BMOD][l * 6144 + c0 + cc];
#pragma unroll
            for (int wv = 0; wv < 8; ++wv) s += red[(wv * 9 + b) * 64 + cc];
            mod[(size_t)(l * 9 + b) * 6144 + c0 + cc] = s; }
        __syncthreads();
    } else {
        const int g = (blockIdx.x - 192) * NTHREADS + tid;
        if (g < 1024) { const int pos = g >> 4, f = g & 15; const float inv = powf(10000.0f, -(float)f / 16.0f); const float ang = (float)pos * inv;
            float* rope = (float*)(ws + WS_ROPE); rope[2 * g] = cosf(ang); rope[2 * g + 1] = sinf(ang); }
        bf16* wsbf = (bf16*)(ws + WS_WSBF);
        for (int i = g; i < 2 * 4 * 128 * 128; i += 32768) wsbf[i] = (bf16)f2bf(p.in[I_BWS][i]);
        bf16* wpt = (bf16*)(ws + WS_WPT);
        { const int i = g; const int lg = i >> 12, rem = i & 4095, d = rem >> 6, c = rem & 63; wpt[i] = (bf16)f2bf(p.in[I_CWP][lg * 4096 + c * 64 + d]); }
    }
    {
        const int gid = blockIdx.x * NTHREADS + tid, GT = gridDim.x * NTHREADS;
        float* ssz = (float*)(ws + WS_SS); for (int i = gid; i < 4 * MALL; i += GT) ssz[i] = 0.f;
        const f32x4* cs = (const f32x4*)p.in[I_CTX]; f32x4* xc = (f32x4*)(ws + WS_XC); for (int i = gid; i < MCTX * DM / 4; i += GT) xc[i] = cs[i];
    }
    phase_transposes(p, lds, 0, 0, gridDim.x);
}

__device__ __forceinline__ void phase_norm(const KP& p, int l, int which, const float* src_lat, const float* src_ctx, int row_lo, int row_hi, float* ss) {
    const int lane = threadIdx.x & 63, wave = threadIdx.x >> 6;
    const int gw = blockIdx.x * NWAVES + wave, NGW = gridDim.x * NWAVES;
    const float* mod = (const float*)(p.ws + WS_MOD);
    const float* g = (which ? p.in[I_GFFN] : p.in[I_GMIX]) + l * DM;
    bf16* H = (bf16*)(p.ws + WS_H);
    f32x4 vn[4];
    {   const int row = row_lo + gw;
        if (row < row_hi) { const float* xr = row >= MLAT ? src_ctx + (size_t)(row - MLAT) * DM : src_lat + (size_t)row * DM;
#pragma unroll
            for (int j = 0; j < 4; ++j) vn[j] = *(const f32x4*)(xr + 4 * lane + 256 * j); } }
    for (int row = row_lo + gw; row < row_hi; row += NGW) {
        const bool isc = row >= MLAT;
        const int bb = isc ? 8 : (row >> 11);
        const float* sc = mod + (size_t)(l * 9 + bb) * 6144 + (which ? 4096 : 1024);
        f32x4 v[4]; float q = 0.f;
#pragma unroll
        for (int j = 0; j < 4; ++j) v[j] = vn[j];
        {   const int rn = row + NGW;
            if (rn < row_hi) { const float* xr = rn >= MLAT ? src_ctx + (size_t)(rn - MLAT) * DM : src_lat + (size_t)rn * DM;
#pragma unroll
                for (int j = 0; j < 4; ++j) vn[j] = *(const f32x4*)(xr + 4 * lane + 256 * j); } }
#pragma unroll
        for (int j = 0; j < 4; ++j) q += (v[j].x * v[j].x + v[j].y * v[j].y) + (v[j].z * v[j].z + v[j].w * v[j].w);
        q = wave_sum(q);
        if (lane == 0) ss[row] = q;
#pragma unroll
        for (int j = 0; j < 4; ++j) { const int col = 4 * lane + 256 * j;
            const f32x4 gg = *(const f32x4*)(g + col), sv = *(const f32x4*)(sc + col);
            const f32x4 y = v[j] * gg * (sv + 1.0f);
            u32x2 w; w.x = pk2(y.x, y.y); w.y = pk2(y.z, y.w);
            *(u32x2*)(H + (size_t)row * DM + col) = w; }
    }
}
__device__ __forceinline__ void phase_norm_ctx(const KP& p, int l, int which, int lg, int goff, const float* part, float* ss) {
    const int lane = threadIdx.x & 63, wave = threadIdx.x >> 6;
    const int gw = blockIdx.x * NWAVES + wave, NGW = gridDim.x * NWAVES;
    const float* mod = (const float*)(p.ws + WS_MOD);
    const float* g = (which ? p.in[I_GFFN] : p.in[I_GMIX]) + l * DM;
    const float* sc = mod + (size_t)(l * 9 + 8) * 6144 + (which ? 4096 : 1024);
    const float* gate = mod + (size_t)(lg * 9 + 8) * 6144 + goff;
    bf16* H = (bf16*)(p.ws + WS_H); float* XC = (float*)(p.ws + WS_XC);
    for (int r = gw; r < MCTX; r += NGW) {
        f32x4 v[4]; float q = 0.f;
#pragma unroll
        for (int j = 0; j < 4; ++j) { const size_t off = (size_t)r * DM + 4 * lane + 256 * j; f32x4 a = *(const f32x4*)(part + off);
#pragma unroll
            for (int sl = 1; sl < 8; ++sl) a += *(const f32x4*)(part + (size_t)sl * MCTX * DM + off);
            v[j] = *(const f32x4*)(XC + off) + *(const f32x4*)(gate + 4 * lane + 256 * j) * a;
            *(f32x4*)(XC + off) = v[j];
            q += (v[j].x * v[j].x + v[j].y * v[j].y) + (v[j].z * v[j].z + v[j].w * v[j].w); }
        q = wave_sum(q);
        if (lane == 0) ss[MLAT + r] = q;
#pragma unroll
        for (int j = 0; j < 4; ++j) { const int col = 4 * lane + 256 * j;
            const f32x4 gg = *(const f32x4*)(g + col), sv = *(const f32x4*)(sc + col);
            const f32x4 y = v[j] * gg * (sv + 1.0f);
            u32x2 w; w.x = pk2(y.x, y.y); w.y = pk2(y.z, y.w);
            *(u32x2*)(H + (size_t)(MLAT + r) * DM + col) = w; }
    }
}
__device__ __forceinline__ void phase_tables(const KP& p, unsigned char* lds, int sel) {
    const int tid = threadIdx.x, lane = tid & 63, wave = tid >> 6;
    const int gw = blockIdx.x * NWAVES + wave, NGW = gridDim.x * NWAVES;
    const float* mod = (const float*)(p.ws + WS_MOD);
    float* gs = (float*)(p.ws + WS_GS);
    if (sel == 0) for (int i = blockIdx.x * NTHREADS + tid; i < 2 * 2 * 9 * 1024; i += gridDim.x * NTHREADS) { const int lw = i / 9216, rem = i - lw * 9216, bb = rem >> 10, col = rem & 1023, l = lw >> 1, which = lw & 1;
        const float g = (which ? p.in[I_GFFN] : p.in[I_GMIX])[l * DM + col]; gs[i] = g * (1.0f + mod[(size_t)(l * 9 + bb) * 6144 + (which ? 4096 : 1024) + col]); }
    const int ntask = sel ? 176 : 64;
    for (int task = blockIdx.x; task < ntask; task += gridDim.x) {
        const int which = sel, l = sel ? task / 88 : task / 32, slab = sel ? task - l * 88 : task - l * 32;
        float* sh = (float*)lds;
        __syncthreads();
        for (int i = tid; i < 9 * 1024; i += NTHREADS) sh[i] = mod[(size_t)(l * 9 + (i >> 10)) * 6144 + (which ? 3072 : 0) + (i & 1023)];
        __syncthreads();
        const int Nn = which ? NGU : NIN, n = slab * 64 + lane;
        const bf16* WT = (which ? (const bf16*)(p.ws + WS_WGU) + (size_t)l * NGU * DM : (const bf16*)(p.ws + WS_WIN) + (size_t)l * NIN * DM) + (size_t)n * DM + wave * 128;
        float acc[9];
#pragma unroll
        for (int b = 0; b < 9; ++b) acc[b] = 0.f;
        u32x4 wr[16];
#pragma unroll
        for (int i = 0; i < 16; ++i) wr[i] = *(const u32x4*)(WT + 8 * i);
#pragma unroll
        for (int i = 0; i < 16; ++i) { float wf[8]; wf[0] = bflo(wr[i].x); wf[1] = bfhi(wr[i].x); wf[2] = bflo(wr[i].y); wf[3] = bfhi(wr[i].y); wf[4] = bflo(wr[i].z); wf[5] = bfhi(wr[i].z); wf[6] = bflo(wr[i].w); wf[7] = bfhi(wr[i].w);
#pragma unroll
            for (int b = 0; b < 9; ++b) { const float* sr = sh + b * 1024 + wave * 128 + 8 * i; const f32x4 a0 = *(const f32x4*)(sr), a1 = *(const f32x4*)(sr + 4);
#pragma unroll
                for (int j = 0; j < 4; ++j) acc[b] += wf[j] * a0[j] + wf[4 + j] * a1[j]; } }
        float* red = (float*)(lds + 40960);
#pragma unroll
        for (int b = 0; b < 9; ++b) red[(wave * 9 + b) * 64 + lane] = acc[b];
        __syncthreads();
        float* out = which ? (float*)(p.ws + WS_BIAS2) + (size_t)l * 9 * NGU : (float*)(p.ws + WS_BIAS1) + (size_t)l * 9 * NIN;
        for (int i = tid; i < 576; i += NTHREADS) { const int b = i >> 6, cc = i & 63; float a = 0.f;
#pragma unroll
            for (int wv = 0; wv < 8; ++wv) a += red[(wv * 9 + b) * 64 + cc];
            out[(size_t)b * Nn + slab * 64 + cc] = a; }
    }
    __syncthreads();
}

__device__ __forceinline__ void prep_head(const u32x4 (&raw)[4], const float* gainL, const float* ropeL, int pos, float scale, int h, u32x4 (&out)[4]) {
    float x[4][8]; float ss = 0.f;
#pragma unroll
    for (int c = 0; c < 4; ++c) { x[c][0] = bflo(raw[c].x); x[c][1] = bfhi(raw[c].x); x[c][2] = bflo(raw[c].y); x[c][3] = bfhi(raw[c].y); x[c][4] = bflo(raw[c].z); x[c][5] = bfhi(raw[c].z); x[c][6] = bflo(raw[c].w); x[c][7] = bfhi(raw[c].w);
#pragma unroll
        for (int i = 0; i < 8; ++i) ss += x[c][i] * x[c][i]; }
    ss += __shfl_xor(ss, 32);
    const float rstd = (1.0f / sqrtf(ss * (1.0f / 64.0f) + EPS)) * scale;
#pragma unroll
    for (int c = 0; c < 4; ++c) { const f32x4 g0 = *(const f32x4*)(gainL + 16 * c + 8 * h), g1 = *(const f32x4*)(gainL + 16 * c + 8 * h + 4);
#pragma unroll
        for (int i = 0; i < 4; ++i) { x[c][i] *= rstd * g0[i]; x[c][4 + i] *= rstd * g1[i]; } }
    if (pos >= 0) {
        const int pr = pos >> 6, pc = pos & 63;
#pragma unroll
        for (int ax = 0; ax < 2; ++ax) { const float* tb = ropeL + ((ax ? pc : pr) * 16 + 8 * h) * 2;
#pragma unroll
            for (int i4 = 0; i4 < 4; ++i4) { const f32x4 cs = *(const f32x4*)(tb + 4 * i4);
#pragma unroll
                for (int e = 0; e < 2; ++e) { const int i = 2 * i4 + e; const float co = cs[2 * e], sn = cs[2 * e + 1]; const float a = x[2 * ax][i], b = x[2 * ax + 1][i];
                    x[2 * ax][i] = a * co - b * sn; x[2 * ax + 1][i] = a * sn + b * co; } } }
    }
#pragma unroll
    for (int c = 0; c < 4; ++c) { out[c].x = pk2(x[c][0], x[c][1]); out[c].y = pk2(x[c][2], x[c][3]); out[c].z = pk2(x[c][4], x[c][5]); out[c].w = pk2(x[c][6], x[c][7]); }
}
__device__ __forceinline__ void phase_prep(const KP& p, int l) {
    const int lane = threadIdx.x & 63, wave = threadIdx.x >> 6, ql = lane & 31, h = lane >> 5;
    const int gw = blockIdx.x * NWAVES + wave, NGW = gridDim.x * NWAVES;
    bf16* P = (bf16*)(p.ws + WS_P); const float* rope = (const float*)(p.ws + WS_ROPE);
    for (int it = gw; it < (MALL / 32) * 14; it += NGW) {
        const int rb = it / 14, slot = it % 14; const int row = rb * 32 + ql;
        int col; const float* gain; bool isq, ropeok;
        if (slot < 4) { col = 64 * slot; gain = p.in[I_AQG] + l * 64; isq = true; ropeok = true; }
        else if (slot < 6) { col = 256 + 64 * (slot - 4); gain = p.in[I_AKG] + l * 64; isq = false; ropeok = true; }
        else if (slot < 10) { col = 1280 + 64 * (slot - 6); gain = p.in[I_DQG] + l * 64; isq = true; ropeok = false; }
        else { col = 1536 + 64 * (slot - 10); gain = p.in[I_DKG] + l * 64; isq = false; ropeok = false; }
        const int pos = (ropeok && row < MLAT) ? (row & (SEQ - 1)) : -1;
        bf16* ptr = P + (size_t)row * NIN + col + 8 * h;
        u32x4 raw[4], o[4];
#pragma unroll
        for (int c = 0; c < 4; ++c) raw[c] = *(const u32x4*)(ptr + 16 * c);
        prep_head(raw, gain, rope, pos, isq ? 0.125f * LOG2E : 1.0f, h, o);
#pragma unroll
        for (int c = 0; c < 4; ++c) *(u32x4*)(ptr + 16 * c) = o[c];
    }
}

constexpr int A_KB = 0, A_KB_SZ = 64 * 144, A_VB = 2 * A_KB_SZ, A_VB_SZ = 64 * 144, A_RPB = A_VB + 2 * A_VB_SZ, A_TAB = A_RPB + 2048, A_END = A_TAB + 256 * 144;

template <int TYPE>
__device__ __forceinline__ void attn_unit(const KP& p, unsigned char* lds, int l, int uidx) {
    int tid_ = threadIdx.x; asm volatile("" : "+v"(tid_));
    const int tid = tid_, lane = tid & 63, wave = __builtin_amdgcn_readfirstlane(tid >> 6), ql = lane & 31, h = lane >> 5;
    const bf16* P = (const bf16*)(p.ws + WS_P); bf16* MIX = (bf16*)(p.ws + WS_MIX);
    int b, qcol, kcol, vcol, ocol, qrow, qpos = 0, NT = 4; float m_i = -1e30f, l_i = 0.f;
    int n = 0, t_lo = 0, wq = 0;
    int hd = 0, c0 = 0, kr_lo = 0, qr = 0, qc = 0, rs_q = 0, cs_q = 0, rsa = 0, rsb = 0, cbq = 0;
    if (TYPE == 0) {
        b = uidx >> 5; const int kh = (uidx >> 4) & 1; n = uidx & 15; const int gi = wave >> 2; wq = wave & 3; const int hq = 2 * kh + gi;
        qpos = n * 128 + 32 * wq + ql; qrow = b * SEQ + qpos; qcol = 64 * hq; kcol = 256 + 64 * kh; vcol = 384 + 64 * kh; ocol = 64 * hq;
        t_lo = (n == 0) ? 2 : 0; const int t_hi = (n == 15) ? 4 : 6; NT = 4 + t_hi - t_lo;
        m_i = p.in[I_ASINK][l * 4 + hq] * LOG2E; l_i = h == 0 ? 1.0f : 0.0f;
    } else if (TYPE == 1) {
        b = uidx >> 5; hd = (uidx >> 3) & 3; const int cb = (uidx >> 1) & 3, rh = uidx & 1; const int ra = 16 * rh + 2 * wave; cbq = cb;
        qr = ra + (ql >> 4); qc = 16 * cb + (ql & 15); qpos = qr * 64 + qc; qrow = b * SEQ + qpos;
        qcol = 1280 + 64 * hd; kcol = 1536 + 64 * hd; vcol = 1792 + 64 * hd; ocol = 768 + 64 * hd;
        c0 = cb == 0 ? 0 : (cb == 1 ? 8 : (cb == 2 ? 24 : 32)); kr_lo = rh ? 12 : 0; NT = 4 + 10;
        rs_q = min(max(qr - 4, 0), 24); cs_q = min(max(qc - 8, 0), 48); rsa = min(max(ra - 4, 0), 24); rsb = min(max(ra - 3, 0), 24);
    } else {
        if (uidx < 32) { b = uidx >> 2; const int kh = (uidx >> 1) & 1, gi = uidx & 1, hq = 2 * kh + gi; qcol = 64 * hq; kcol = 256 + 64 * kh; vcol = 384 + 64 * kh; ocol = 64 * hq;
            m_i = p.in[I_ASINK][l * 4 + hq] * LOG2E; l_i = h == 0 ? 1.0f : 0.0f; }
        else { const int uu = uidx - 32; b = uu >> 2; hd = uu & 3; qcol = 1280 + 64 * hd; kcol = 1536 + 64 * hd; vcol = 1792 + 64 * hd; ocol = 768 + 64 * hd; }
        qrow = MLAT + b * CTXL + 32 * wave + ql;
    }
    const int ctx_row0 = MLAT + b * CTXL;
    float* rpbL = (float*)(lds + A_RPB);
    float* tab = (float*)(lds + A_TAB);
    if (TYPE == 1) {
        const int ro = tid >> 5, qcl = (tid >> 1) & 15, hf = tid & 1; const int qcc = 16 * cbq + qcl, csq = min(max(qcc - 8, 0), 48);
        const float* rb = p.in[I_RPB] + (size_t)(l * 4 + hd) * 465 + ro * 31 + 15 - qcc;
        float* dst = tab + (ro * 16 + qcl) * 36 + 16 * hf;
#pragma unroll
        for (int j = 0; j < 16; ++j) { const int kc = c0 + 16 * hf + j; const bool ok = (ro < 15) && ((unsigned)(kc - csq) < 16u); float v = -1e30f; if (ok) v = rb[kc] * LOG2E; dst[j] = v; }
    }
    bf16x8 qf[4];
#pragma unroll
    for (int c = 0; c < 4; ++c) qf[c] = *(const bf16x8*)(P + (size_t)qrow * NIN + qcol + 16 * c + 8 * h);
    const int skey = tid & 63, sch = tid >> 6, sk31 = skey & 31;
    const int vpos = 32 * (skey >> 5) + 16 * (sk31 >> 4) + 8 * ((sk31 >> 2) & 1) + 4 * ((sk31 >> 3) & 1) + (sk31 & 3);
    u32x4 kraw, vraw;
#define TILE_ROW(t, krow_) do { if ((t) < 4) krow_ = ctx_row0 + 64 * (t) + skey; \
        else if (TYPE == 0) krow_ = b * SEQ + (n - 1) * 128 + 64 * (t_lo + (t) - 4) + skey; \
        else krow_ = b * SEQ + (kr_lo + 2 * ((t) - 4) + (skey >> 5)) * 64 + c0 + sk31; } while (0)
#define STAGE_LOAD(t) do { int krow_; TILE_ROW(t, krow_); kraw = *(const u32x4*)(P + (size_t)krow_ * NIN + kcol + 8 * sch); vraw = *(const u32x4*)(P + (size_t)krow_ * NIN + vcol + 8 * sch); } while (0)
#define STAGE_STORE(buf) do { *(u32x4*)(lds + A_KB + (buf) * A_KB_SZ + skey * 144 + sch * 16) = kraw; \
        unsigned short* vb_ = (unsigned short*)(lds + A_VB + (buf) * A_VB_SZ) + (8 * sch) * 72 + vpos; \
        vb_[0 * 72] = (unsigned short)(vraw.x & 0xffffu); vb_[1 * 72] = (unsigned short)(vraw.x >> 16); vb_[2 * 72] = (unsigned short)(vraw.y & 0xffffu); vb_[3 * 72] = (unsigned short)(vraw.y >> 16); \
        vb_[4 * 72] = (unsigned short)(vraw.z & 0xffffu); vb_[5 * 72] = (unsigned short)(vraw.z >> 16); vb_[6 * 72] = (unsigned short)(vraw.w & 0xffffu); vb_[7 * 72] = (unsigned short)(vraw.w >> 16); } while (0)
    STAGE_LOAD(0);
    STAGE_STORE(0);
    __syncthreads();
    f32x16 O0, O1;
#pragma unroll
    for (int i = 0; i < 16; ++i) { O0[i] = 0.f; O1[i] = 0.f; }
    for (int t = 0; t < NT; ++t) {
        const int cur = t & 1; const bool more = (t + 1) < NT;
        if (more) STAGE_LOAD(t + 1);
        bool need = true;
        if (t >= 4) { if (TYPE == 0) { const int j0 = 2 * (t_lo + t - 4); need = (j0 + 1 >= wq) && (j0 <= wq + 8); } else if (TYPE == 1) { const int kr = kr_lo + 2 * (t - 4); need = (kr + 1 >= rsa) && (kr < rsb + 8); } }
        if (need) {
            f32x16 s0, s1;
#pragma unroll
            for (int i = 0; i < 16; ++i) { s0[i] = 0.f; s1[i] = 0.f; }
            const unsigned char* kb = lds + A_KB + cur * A_KB_SZ + ql * 144 + h * 16;
#pragma unroll
            for (int c = 0; c < 4; ++c) { s0 = mfma32(*(const bf16x8*)(kb + 32 * c), qf[c], s0); s1 = mfma32(*(const bf16x8*)(kb + 32 * 144 + 32 * c), qf[c], s1); }
            if (t >= 4) {
                if (TYPE == 0) { const int kp0 = (n - 1) * 128 + 64 * (t_lo + t - 4) + 4 * h - qpos; const int kq0 = (n - 1) * 128 + 64 * (t_lo + t - 4) - (n * 128 + 32 * wq);
                  if (kq0 < 31 - 128 || kq0 + 63 > 128)
#pragma unroll
                    for (int i = 0; i < 16; ++i) { const unsigned du = (unsigned)(kp0 + 128) + (unsigned)(8 * (i >> 2) + (i & 3));
                        s0[i] = (du <= 256u) ? s0[i] : -1e30f; s1[i] = (du + 32u <= 256u) ? s1[i] : -1e30f; } }
                else if (TYPE == 1) { const int kr = kr_lo + 2 * (t - 4);
                    const int ro0 = ((unsigned)(kr - rs_q) < 8u) ? (kr - qr + 7) : 15, ro1 = ((unsigned)(kr + 1 - rs_q) < 8u) ? (kr + 1 - qr + 7) : 15;
                    const float* t0 = tab + (ro0 * 16 + (ql & 15)) * 36 + 4 * h; const float* t1 = tab + (ro1 * 16 + (ql & 15)) * 36 + 4 * h;
#pragma unroll
                    for (int g = 0; g < 4; ++g) { const f32x4 a = *(const f32x4*)(t0 + 8 * g), bq = *(const f32x4*)(t1 + 8 * g);
#pragma unroll
                        for (int j = 0; j < 4; ++j) { s0[4 * g + j] += a[j]; s1[4 * g + j] += bq[j]; } } }
            }
            const float PINF = __builtin_inff();
            float mxa = __builtin_amdgcn_fmed3f(s0[0], s0[1], PINF), mxb = __builtin_amdgcn_fmed3f(s0[8], s0[9], PINF), mxc = __builtin_amdgcn_fmed3f(s1[0], s1[1], PINF), mxd = __builtin_amdgcn_fmed3f(s1[8], s1[9], PINF);
#pragma unroll
            for (int i = 2; i < 8; ++i) { mxa = __builtin_amdgcn_fmed3f(mxa, s0[i], PINF); mxb = __builtin_amdgcn_fmed3f(mxb, s0[8 + i], PINF); mxc = __builtin_amdgcn_fmed3f(mxc, s1[i], PINF); mxd = __builtin_amdgcn_fmed3f(mxd, s1[8 + i], PINF); }
            float mx = __builtin_amdgcn_fmed3f(__builtin_amdgcn_fmed3f(mxa, mxb, PINF), __builtin_amdgcn_fmed3f(mxc, mxd, PINF), PINF);
            mx = fmaxf(mx, __shfl_xor(mx, 32));
            const bool anyg = __builtin_amdgcn_ballot_w64(mx > m_i + 8.0f) != 0ull;
            const float mn = anyg ? fmaxf(m_i, mx) : m_i; const float alpha = __builtin_amdgcn_exp2f(m_i - mn); m_i = mn;
            float la = 0.f, lb = 0.f, lc = 0.f, ld = 0.f;
#pragma unroll
            for (int i = 0; i < 16; i += 2) { s0[i] = __builtin_amdgcn_exp2f(s0[i] - mn); s0[i + 1] = __builtin_amdgcn_exp2f(s0[i + 1] - mn); s1[i] = __builtin_amdgcn_exp2f(s1[i] - mn); s1[i + 1] = __builtin_amdgcn_exp2f(s1[i + 1] - mn);
                la += s0[i]; lb += s0[i + 1]; lc += s1[i]; ld += s1[i + 1]; }
            l_i = l_i * alpha + ((la + lb) + (lc + ld));
            if (__builtin_amdgcn_ballot_w64(alpha != 1.0f) != 0ull) {
#pragma unroll
                for (int i = 0; i < 16; ++i) { O0[i] *= alpha; O1[i] *= alpha; } }
            u32x4 pw0, pw1, pw2, pw3;
            pw0.x = pk2(s0[0], s0[1]); pw0.y = pk2(s0[2], s0[3]); pw0.z = pk2(s0[4], s0[5]); pw0.w = pk2(s0[6], s0[7]);
            pw1.x = pk2(s0[8], s0[9]); pw1.y = pk2(s0[10], s0[11]); pw1.z = pk2(s0[12], s0[13]); pw1.w = pk2(s0[14], s0[15]);
            pw2.x = pk2(s1[0], s1[1]); pw2.y = pk2(s1[2], s1[3]); pw2.z = pk2(s1[4], s1[5]); pw2.w = pk2(s1[6], s1[7]);
            pw3.x = pk2(s1[8], s1[9]); pw3.y = pk2(s1[10], s1[11]); pw3.z = pk2(s1[12], s1[13]); pw3.w = pk2(s1[14], s1[15]);
            const bf16x8 pf0 = as_bf16x8(pw0), pf1 = as_bf16x8(pw1), pf2 = as_bf16x8(pw2), pf3 = as_bf16x8(pw3);
            const unsigned char* vb = lds + A_VB + cur * A_VB_SZ + ql * 144 + h * 16;
            O0 = mfma32(*(const bf16x8*)(vb), pf0, O0); O0 = mfma32(*(const bf16x8*)(vb + 32), pf1, O0); O0 = mfma32(*(const bf16x8*)(vb + 64), pf2, O0); O0 = mfma32(*(const bf16x8*)(vb + 96), pf3, O0);
            O1 = mfma32(*(const bf16x8*)(vb + 32 * 144), pf0, O1); O1 = mfma32(*(const bf16x8*)(vb + 32 * 144 + 32), pf1, O1); O1 = mfma32(*(const bf16x8*)(vb + 32 * 144 + 64), pf2, O1); O1 = mfma32(*(const bf16x8*)(vb + 32 * 144 + 96), pf3, O1);
        }
        if (more) STAGE_STORE(cur ^ 1);
        __syncthreads();
    }
#undef TILE_ROW
#undef STAGE_LOAD
#undef STAGE_STORE
    const float lt = l_i + __shfl_xor(l_i, 32); const float inv = 1.0f / lt;
    bf16* orow = MIX + (size_t)qrow * DM + ocol + 4 * h;
#pragma unroll
    for (int g4 = 0; g4 < 4; ++g4) {
        u32x2 w0, w1; w0.x = pk2(O0[4 * g4] * inv, O0[4 * g4 + 1] * inv); w0.y = pk2(O0[4 * g4 + 2] * inv, O0[4 * g4 + 3] * inv);
        w1.x = pk2(O1[4 * g4] * inv, O1[4 * g4 + 1] * inv); w1.y = pk2(O1[4 * g4 + 2] * inv, O1[4 * g4 + 3] * inv);
        *(u32x2*)(orow + 8 * g4) = w0; *(u32x2*)(orow + 32 + 8 * g4) = w1; }
}

__device__ __forceinline__ void sgu_unit(const KP& p, unsigned char* lds, int l, int R0) {
    int tid_ = threadIdx.x; asm volatile("" : "+v"(tid_));
    const int tid = tid_, lane = tid & 63, wave = __builtin_amdgcn_readfirstlane(tid >> 6), ql = lane & 31, h = lane >> 5;
    const bf16* P = (const bf16*)(p.ws + WS_P); bf16* MIX = (bf16*)(p.ws + WS_MIX);
    constexpr int VP = 136;
    unsigned short* Vt = (unsigned short*)lds;
    {
        const int token = tid >> 2, qtr = tid & 3;
        const u32x4* src = (const u32x4*)(P + (size_t)(R0 + token) * NIN + 768 + 64 * qtr);
        float v[64]; float s = 0.f;
#pragma unroll
        for (int j = 0; j < 8; ++j) { const u32x4 r = src[j];
            v[8 * j + 0] = gelu_tanh(bflo(r.x)); v[8 * j + 1] = gelu_tanh(bfhi(r.x)); v[8 * j + 2] = gelu_tanh(bflo(r.y)); v[8 * j + 3] = gelu_tanh(bfhi(r.y));
            v[8 * j + 4] = gelu_tanh(bflo(r.z)); v[8 * j + 5] = gelu_tanh(bfhi(r.z)); v[8 * j + 6] = gelu_tanh(bflo(r.w)); v[8 * j + 7] = gelu_tanh(bfhi(r.w)); }
#pragma unroll
        for (int i = 0; i < 64; ++i) s += v[i];
        s += __shfl_xor(s, 1); s += __shfl_xor(s, 2);
        const float mu = s * (1.0f / 256.0f); float q = 0.f;
#pragma unroll
        for (int i = 0; i < 64; ++i) { v[i] -= mu; q += v[i] * v[i]; }
        q += __shfl_xor(q, 1); q += __shfl_xor(q, 2);
        const float rstd = 1.0f / sqrtf(q * (1.0f / 256.0f) + EPS);
        const float* gn = p.in[I_BVG] + l * 256 + 64 * qtr;
#pragma unroll
        for (int i = 0; i < 64; ++i) Vt[(64 * qtr + i) * VP + token] = (unsigned short)f2bf(v[i] * rstd * gn[i]);
    }
    __syncthreads();
    const int g = wave >> 1, ph = wave & 1;
    f32x16 acc[2][2];
#pragma unroll
    for (int a = 0; a < 2; ++a)
#pragma unroll
        for (int c = 0; c < 2; ++c)
#pragma unroll
            for (int i = 0; i < 16; ++i) acc[a][c][i] = 0.f;
    const bf16* Wg = (const bf16*)(p.ws + WS_WSBF) + (size_t)(l * 4 + g) * 128 * 128;
#pragma unroll 2
    for (int s = 0; s < 8; ++s) {
        bf16x8 a[2], bq[2];
#pragma unroll
        for (int mb = 0; mb < 2; ++mb) a[mb] = *(const bf16x8*)(Vt + (64 * g + 32 * mb + ql) * VP + 16 * s + 8 * h);
#pragma unroll
        for (int nb = 0; nb < 2; ++nb) bq[nb] = *(const bf16x8*)(Wg + (64 * ph + 32 * nb + ql) * 128 + 16 * s + 8 * h);
#pragma unroll
        for (int mb = 0; mb < 2; ++mb)
#pragma unroll
            for (int nb = 0; nb < 2; ++nb) acc[mb][nb] = mfma32(a[mb], bq[nb], acc[mb][nb]);
    }
    u32x2 upre[2][2][4]; float bpre[2];
#pragma unroll
    for (int nb = 0; nb < 2; ++nb) { const int pp = 64 * ph + 32 * nb + ql; const size_t row = (size_t)(R0 + pp); bpre[nb] = p.in[I_BBS][(l * 4 + g) * 128 + pp];
#pragma unroll
        for (int mb = 0; mb < 2; ++mb)
#pragma unroll
            for (int g4 = 0; g4 < 4; ++g4) upre[nb][mb][g4] = *(const u32x2*)(P + row * NIN + 512 + 64 * g + 32 * mb + 8 * g4 + 4 * h); }
#pragma unroll
    for (int nb = 0; nb < 2; ++nb) { const int pp = 64 * ph + 32 * nb + ql; const size_t row = (size_t)(R0 + pp); const float bias = bpre[nb];
#pragma unroll
        for (int mb = 0; mb < 2; ++mb)
#pragma unroll
            for (int g4 = 0; g4 < 4; ++g4) { const int c = 64 * g + 32 * mb + 8 * g4 + 4 * h;
                const u32x2 ur = upre[nb][mb][g4];
                const float o0 = gelu_tanh(bflo(ur.x)) * (acc[mb][nb][4 * g4 + 0] + bias), o1 = gelu_tanh(bfhi(ur.x)) * (acc[mb][nb][4 * g4 + 1] + bias);
                const float o2 = gelu_tanh(bflo(ur.y)) * (acc[mb][nb][4 * g4 + 2] + bias), o3 = gelu_tanh(bfhi(ur.y)) * (acc[mb][nb][4 * g4 + 3] + bias);
                u32x2 w; w.x = pk2(o0, o1); w.y = pk2(o2, o3);
                *(u32x2*)(MIX + row * DM + 256 + c) = w; } }
    __syncthreads();
}

__device__ __forceinline__ void pool_unit(const KP& p, unsigned char* lds, int l, int segrow, int nseg, int t0) {
    int tid_ = threadIdx.x; asm volatile("" : "+v"(tid_));
    const int tid = tid_, lane = tid & 63, wave = __builtin_amdgcn_readfirstlane(tid >> 6), ql = lane & 31, h = lane >> 5;
    const bf16* P = (const bf16*)(p.ws + WS_P); bf16* MIX = (bf16*)(p.ws + WS_MIX);
    constexpr int RP = 528;
    for (int i = tid; i < 144 * 32; i += NTHREADS) { const int r = i >> 5, ch = i & 31, t = t0 - 8 + r; u32x4 val = (u32x4){0u, 0u, 0u, 0u};
        if (t >= 0 && t < nseg) val = *(const u32x4*)(P + (size_t)(segrow + t) * NIN + 1024 + 8 * ch);
        *(u32x4*)(lds + r * RP + ch * 16) = val; }
    __syncthreads();
    const int tb = wave & 3, gp = wave >> 2, tl = 32 * tb + ql, t = t0 + tl;
    const size_t row = (size_t)(segrow + t);
    for (int gs = 0; gs < 2; ++gs) {
        const int gi = 2 * gp + gs, half = 1 << gi;
        const int lo = max(t - half, 0), hi = min(t + half, nseg); const float inv = 1.0f / (float)(hi - lo);
        f32x16 acc[2];
#pragma unroll
        for (int a = 0; a < 2; ++a)
#pragma unroll
            for (int i = 0; i < 16; ++i) acc[a][i] = 0.f;
        const bf16* Wp = (const bf16*)(p.ws + WS_WPT) + (size_t)(l * 4 + gi) * 64 * 64;
        for (int s = 0; s < 4; ++s) {
            const unsigned char* base = lds + (tl + 8) * RP + (64 * gi + 16 * s + 8 * h) * 2;
            float sm[8];
#pragma unroll
            for (int i = 0; i < 8; ++i) sm[i] = 0.f;
            for (int r = -half; r < half; ++r) { const u32x4 v = *(const u32x4*)(base + r * RP);
                sm[0] += bflo(v.x); sm[1] += bfhi(v.x); sm[2] += bflo(v.y); sm[3] += bfhi(v.y); sm[4] += bflo(v.z); sm[5] += bfhi(v.z); sm[6] += bflo(v.w); sm[7] += bfhi(v.w); }
            const u32x4 sv = *(const u32x4*)(base);
            u32x4 w; w.x = pk2(sm[0] * inv - bflo(sv.x), sm[1] * inv - bfhi(sv.x)); w.y = pk2(sm[2] * inv - bflo(sv.y), sm[3] * inv - bfhi(sv.y));
            w.z = pk2(sm[4] * inv - bflo(sv.z), sm[5] * inv - bfhi(sv.z)); w.w = pk2(sm[6] * inv - bflo(sv.w), sm[7] * inv - bfhi(sv.w));
            const bf16x8 bfr = as_bf16x8(w);
#pragma unroll
            for (int mb = 0; mb < 2; ++mb) { const bf16x8 a = *(const bf16x8*)(Wp + (32 * mb + ql) * 64 + 16 * s + 8 * h); acc[mb] = mfma32(a, bfr, acc[mb]); }
        }
        f32x4 scp[2][4];
#pragma unroll
        for (int mb = 0; mb < 2; ++mb)
#pragma unroll
            for (int g4 = 0; g4 < 4; ++g4) scp[mb][g4] = *(const f32x4*)(p.in[I_CSC] + l * 256 + 64 * gi + 32 * mb + 8 * g4 + 4 * h);
#pragma unroll
        for (int mb = 0; mb < 2; ++mb)
#pragma unroll
            for (int g4 = 0; g4 < 4; ++g4) { const int d = 32 * mb + 8 * g4 + 4 * h; const f32x4 sc = scp[mb][g4];
                u32x2 w; w.x = pk2(acc[mb][4 * g4] * sc.x, acc[mb][4 * g4 + 1] * sc.y); w.y = pk2(acc[mb][4 * g4 + 2] * sc.z, acc[mb][4 * g4 + 3] * sc.w);
                *(u32x2*)(MIX + row * DM + 512 + 64 * gi + d) = w; }
    }
    __syncthreads();
}

__device__ __forceinline__ void phase_mixer(const KP& p, unsigned char* lds, int l, const XcdBarrier& bar) {
    for (int u = blockIdx.x; u < 768; u += gridDim.x) {
        if (u < 256) attn_unit<1>(p, lds, l, u);
        else if (u < 512) attn_unit<0>(p, lds, l, u - 256);
        else if (u < 640) sgu_unit(p, lds, l, (u - 512) * 128);
        else { const int ch = u - 640; pool_unit(p, lds, l, (ch >> 4) * SEQ, SEQ, (ch & 15) * 128); }
    }
    if (l == 0) {
        const int G = (int)gridDim.x, first = G > 96 ? G - 96 : 0;
        for (int cu = (int)blockIdx.x - first; cu < 96; cu += G) { if (cu < 0) continue;
            if (cu < 64) attn_unit<2>(p, lds, l, cu);
            else if (cu < 80) sgu_unit(p, lds, l, MLAT + (cu - 64) * 128);
            else { const int ch = cu - 80; pool_unit(p, lds, l, MLAT + (ch >> 1) * CTXL, CTXL, (ch & 1) * 128); } }
    }
}

template <int L>
__device__ __forceinline__ void ph_g1(unsigned char* lds, const float* ss) {
    const KP p = make_kp(); unsigned char* ws = p.ws;
    pg8::Gemm g{(const pg8::bf16_t*)(ws + WS_H), (const pg8::bf16_t*)(ws + WS_WIN) + (size_t)L * NIN * DM, MALL, NIN, DM, DM}; pg8::StaticOrder S; S.init(MALL, NIN, gridDim.x, blockIdx.x);
    {   const f32x4* rsrc = (const f32x4*)(ws + WS_ROPE); LAS f32x4* rdst = (LAS f32x4*)((LAS unsigned char*)lds + LDS_ROPE);
        rdst[threadIdx.x] = rsrc[threadIdx.x]; __syncthreads(); }
    EpiG1 E{(bf16*)(ws + WS_P), ss, (const float*)(ws + WS_BIAS1) + (size_t)L * 9 * NIN, p.in[I_AQG] + L * 64, p.in[I_AKG] + L * 64, p.in[I_DQG] + L * 64, p.in[I_DKG] + L * 64, (const LAS float*)((LAS unsigned char*)lds + LDS_ROPE)};
    pg8::gemm_phase<EpiG1, pg8::StaticOrder, true, true>((PG8_LAS unsigned char*)lds, g, S, E);
    if (L == 0) {
        const KP p2 = make_kp(); const int G = (int)gridDim.x, nwg = (MALL / 256) * (NIN / 256), rem = nwg % G;
        __syncthreads();
        phase_transposes(p2, lds, 1, rem, G - rem);
    }
}
template <int L>
__device__ __forceinline__ void ph_g2(unsigned char* lds, float* ss) {
    const KP p = make_kp(); unsigned char* ws = p.ws;
    {   pg8::Gemm g{(const pg8::bf16_t*)(ws + WS_MIX), (const pg8::bf16_t*)(ws + WS_WOUT) + (size_t)L * DM * DM, MLAT, DM, DM, DM}; pg8::StaticOrder S; S.init(MLAT, DM, gridDim.x, blockIdx.x);
        EpiResGate<true> E{L == 0 ? p.in[I_X] : p.out, p.out, (const float*)(ws + WS_MOD) + (size_t)L * 9 * 6144 + 2048, (bf16*)(ws + WS_H), ss, (const float*)(ws + WS_GS) + (size_t)(L * 2 + 1) * 9 * 1024};
        pg8::gemm_phase<EpiResGate<true>, pg8::StaticOrder, true, true>((PG8_LAS unsigned char*)lds, g, S, E); }
    if (L == 0) {
        pg8::Gemm g{(const pg8::bf16_t*)(ws + WS_MIX) + (size_t)MLAT * DM, (const pg8::bf16_t*)(ws + WS_WOUT) + (size_t)L * DM * DM, MCTX, DM, 128, DM}; SplitKOrder S; S.init(MCTX / 256, DM / 256, 8, gridDim.x, blockIdx.x, 0);
        EpiPartial E{(float*)(ws + WS_PART2), 0};
        pg8::gemm_phase<EpiPartial, SplitKOrder, true, true>((PG8_LAS unsigned char*)lds, g, S, E); }
}
template <int L>
__device__ __forceinline__ void ph_g3(unsigned char* lds, const float* ss) {
    const KP p = make_kp(); unsigned char* ws = p.ws;
    constexpr int M = (L == 0) ? MALL : MLAT;
    pg8::Gemm g{(const pg8::bf16_t*)(ws + WS_H), (const pg8::bf16_t*)(ws + WS_WGU) + (size_t)L * NGU * DM, M, NGU, DM, DM}; pg8::StaticOrder S; S.init(M, NGU, gridDim.x, blockIdx.x);
    EpiSwiglu E{(bf16*)(ws + WS_HID), ss, (const float*)(ws + WS_BIAS2) + (size_t)L * 9 * NGU};
    pg8::gemm_phase<EpiSwiglu, pg8::StaticOrder, true, true>((PG8_LAS unsigned char*)lds, g, S, E);
}
template <int L>
__device__ __forceinline__ void ph_g4(unsigned char* lds, float* ss) {
    const KP p = make_kp(); unsigned char* ws = p.ws;
    {   pg8::Gemm g{(const pg8::bf16_t*)(ws + WS_HID), (const pg8::bf16_t*)(ws + WS_WD) + (size_t)L * DM * FF, MLAT, DM, FF, FF}; pg8::StaticOrder S; S.init(MLAT, DM, gridDim.x, blockIdx.x);
        EpiResGate<L == 0> E{p.out, p.out, (const float*)(ws + WS_MOD) + (size_t)L * 9 * 6144 + 5120, (bf16*)(ws + WS_H), ss, (const float*)(ws + WS_GS) + (size_t)(1 * 2 + 0) * 9 * 1024};
        pg8::gemm_phase<EpiResGate<L == 0>, pg8::StaticOrder, true, true>((PG8_LAS unsigned char*)lds, g, S, E); }
    if (L == 0) {
        {   pg8::Gemm g{(const pg8::bf16_t*)(ws + WS_HID) + (size_t)MLAT * FF, (const pg8::bf16_t*)(ws + WS_WD) + (size_t)L * DM * FF, MCTX, DM, 384, FF}; SplitKOrder S; S.init(MCTX / 256, DM / 256, 6, gridDim.x, blockIdx.x, 0);
            EpiPartial E{(float*)(ws + WS_PART4), 0};
            pg8::gemm_phase<EpiPartial, SplitKOrder, true, true>((PG8_LAS unsigned char*)lds, g, S, E); }
        {   pg8::Gemm g{(const pg8::bf16_t*)(ws + WS_HID) + (size_t)MLAT * FF + 2304, (const pg8::bf16_t*)(ws + WS_WD) + (size_t)L * DM * FF + 2304, MCTX, DM, 256, FF}; SplitKOrder S; S.init(MCTX / 256, DM / 256, 2, gridDim.x, blockIdx.x, 192);
            EpiPartial E{(float*)(ws + WS_PART4), 6};
            pg8::gemm_phase<EpiPartial, SplitKOrder, true, true>((PG8_LAS unsigned char*)lds, g, S, E); } }
}
#define PH_IN(k) (lo <= (k) && (k) < hi)
#define PH_SYNC(k) do { if (lo <= (k) && (k) + 1 < hi) xcd_barrier(bar); } while (0)
__global__ void __launch_bounds__(NTHREADS, 2) fwd_kernel(Params p) {
    extern __shared__ __attribute__((aligned(16))) unsigned char lds[];
    cg::grid_group grid = cg::this_grid();
    const int lo = p.ph_lo, hi = p.ph_hi;
    volatile LAS unsigned* bst = (volatile LAS unsigned*)((LAS unsigned char*)lds + 131072 + 64);
    if (threadIdx.x < 2) bst[threadIdx.x] = 0u;
    unsigned* barw = (unsigned*)(p.ws + WS_BAR);
    if (PH_IN(0)) {
        const KP kp = make_kp(); phase_prologue(kp, lds);
    }
    if (hi > 1000) grid.sync();
    XcdBarrier bar = xcd_barrier_post(barw, bst);
    __syncthreads();
    PH_SYNC(0);
    float* SS = (float*)(p.ws + WS_SS);
    if (PH_IN(1)) { const KP kp = make_kp(); phase_norm(kp, 0, 0, kp.in[I_X], kp.in[I_CTX], 0, MALL, SS); phase_tables(kp, lds, 0); }
    PH_SYNC(1);
    if (PH_IN(2)) ph_g1<0>(lds, SS);
    PH_SYNC(2);
    if (PH_IN(3)) { const KP kp = make_kp(); phase_mixer(kp, lds, 0, bar); }
    PH_SYNC(3);
    if (PH_IN(4)) ph_g2<0>(lds, SS + MALL);
    PH_SYNC(4);
    if (PH_IN(5)) { const KP kp = make_kp(); phase_norm_ctx(kp, 0, 1, 0, 2048, (const float*)(kp.ws + WS_PART2), SS + MALL); phase_tables(kp, lds, 1); }
    PH_SYNC(5);
    if (PH_IN(6)) ph_g3<0>(lds, SS + MALL);
    PH_SYNC(6);
    if (PH_IN(7)) ph_g4<0>(lds, SS + 2 * MALL);
    PH_SYNC(7);
    if (PH_IN(8)) { const KP kp = make_kp(); phase_norm_ctx(kp, 1, 0, 0, 5120, (const float*)(kp.ws + WS_PART4), SS + 2 * MALL); }
    PH_SYNC(8);
    if (PH_IN(9)) ph_g1<1>(lds, SS + 2 * MALL);
    PH_SYNC(9);
    if (PH_IN(10)) { const KP kp = make_kp(); phase_mixer(kp, lds, 1, bar); }
    PH_SYNC(10);
    if (PH_IN(11)) ph_g2<1>(lds, SS + 3 * MALL);
    PH_SYNC(11);
    if (PH_IN(12)) ph_g3<1>(lds, SS + 3 * MALL);
    PH_SYNC(12);
    if (PH_IN(13)) ph_g4<1>(lds, nullptr);
}
}

#ifndef MK_MULTI
#define MK_MULTI 0
#endif
extern "C" void kernel_launch(void* const* d_in, const int* in_sizes, int n_in, void* d_out, int out_size, void* d_ws, size_t ws_size, hipStream_t stream) {
    using namespace mk;
    static int grid = 0;
    if (grid == 0) {
        if (n_in != 24 || out_size != MLAT * DM || ws_size < WS_END) { fprintf(stderr, "kernel_launch: unexpected problem (n_in %d out %d ws %zu need %zu)\n", n_in, out_size, ws_size, (size_t)WS_END); grid = -1; return; }
        int dev = 0, cus = 0, per_cu = 0;
        hipGetDevice(&dev); hipDeviceGetAttribute(&cus, hipDeviceAttributeMultiprocessorCount, dev);
        if (hipFuncSetAttribute((const void*)fwd_kernel, hipFuncAttributeMaxDynamicSharedMemorySize, LDS_BYTES) != hipSuccess) { fprintf(stderr, "kernel_launch: hipFuncSetAttribute failed\n"); grid = -1; return; }
        if (hipOccupancyMaxActiveBlocksPerMultiprocessor(&per_cu, (const void*)fwd_kernel, NTHREADS, LDS_BYTES) != hipSuccess || per_cu < 1) { fprintf(stderr, "kernel_launch: occupancy query gives %d\n", per_cu); per_cu = 1; }
        (void)hipGetLastError();
        grid = cus * per_cu;
        fprintf(stderr, "kernel_launch: grid %d (cus %d x %d)\n", grid, cus, per_cu);
    }
    if (grid < 0) return;
    if (hipMemsetAsync((char*)d_ws + WS_BAR, 0, 16384, stream) != hipSuccess) { fprintf(stderr, "kernel_launch: memset failed\n"); return; }
    Params p{};
    for (int i = 0; i < 24; ++i) p.in[i] = (const float*)d_in[i];
    p.out = (float*)d_out; p.ws = (unsigned char*)d_ws;
#if MK_MULTI
    for (int ph = 0; ph < 15; ++ph) { p.ph_lo = ph; p.ph_hi = ph + 1; hipLaunchKernelGGL(fwd_kernel, dim3(grid), dim3(NTHREADS), LDS_BYTES, stream, p); }
#else
    p.ph_lo = 0; p.ph_hi = 14;
    void* args[] = {&p};
    hipError_t e = hipLaunchCooperativeKernel((const void*)fwd_kernel, dim3(grid), dim3(NTHREADS), args, LDS_BYTES, stream);
    if (e != hipSuccess) fprintf(stderr, "cooperative launch failed: %s (grid %d)\n", hipGetErrorString(e), grid);
#endif
}
```
